# Optimizing an MI355X kernel written in HIP

```python
import jax, jax.numpy as jnp
from jax import lax
import numpy as np

D_MODEL = 1024
BATCH = 8
SEQ = 2048
DEPTH = 2

HEAD_DIM = 64
NA_HEADS = 8
GQA_Q_HEADS = 8
GQA_KV_HEADS = 2
GRID_W = 64
NA_WIN_ROWS = 8
NA_WIN_COLS = 16
SWA_WINDOW = 128
SWA_BLOCK = 128
ROPE_THETA = 10000.0
PEER_HEADS = 8
PEER_N_KEYS = 128
PEER_N_EXPERTS = PEER_N_KEYS * PEER_N_KEYS
PEER_TOPK = 16
PEER_KEY_DIM = 256
PEER_CHUNK = 128
N_BRANCH = 2
EPS = 1e-6

NA_WIDTH = NA_HEADS * HEAD_DIM
GQA_Q_WIDTH = GQA_Q_HEADS * HEAD_DIM
GQA_KV_WIDTH = GQA_KV_HEADS * HEAD_DIM
IN_SPLITS = (NA_WIDTH, 2 * NA_WIDTH, 3 * NA_WIDTH,
             3 * NA_WIDTH + GQA_Q_WIDTH,
             3 * NA_WIDTH + GQA_Q_WIDTH + GQA_KV_WIDTH,
             3 * NA_WIDTH + GQA_Q_WIDTH + 2 * GQA_KV_WIDTH)
IN_COLS = IN_SPLITS[-1] + N_BRANCH * D_MODEL

kernel_name = "hybrid_natten_swa_peer_encoder"


def rms_norm(x, g):
    xf = x.astype(jnp.float32)
    y = xf * lax.rsqrt(jnp.mean(xf * xf, axis=-1, keepdims=True) + EPS)
    return (y * g.astype(jnp.float32)).astype(x.dtype)


def rotary(x, pos):
    half = x.shape[-1] // 2
    inv = ROPE_THETA ** (-jnp.arange(half, dtype=jnp.float32) / half)
    ang = pos.astype(jnp.float32)[:, None] * inv[None, :]
    cos = jnp.cos(ang)[None, :, None, :]
    sin = jnp.sin(ang)[None, :, None, :]
    xf = x.astype(jnp.float32)
    x1, x2 = xf[..., :half], xf[..., half:]
    out = jnp.concatenate([x1 * cos - x2 * sin, x1 * sin + x2 * cos], axis=-1)
    return out.astype(x.dtype)


def neighbourhood_attention(q, k, v, rpb):
    B, S, H, dh = q.shape
    rows = S // GRID_W
    kr = min(NA_WIN_ROWS, rows)
    r = jnp.arange(rows)
    rs = jnp.clip(r - kr // 2, 0, rows - kr)
    key_rows = rs[:, None] + jnp.arange(kr)[None, :]
    c = jnp.arange(GRID_W)
    cs = jnp.clip(c - NA_WIN_COLS // 2, 0, GRID_W - NA_WIN_COLS)
    qg = q.reshape(B, rows, GRID_W, H, dh)
    kg = k.reshape(B, rows, GRID_W, H, dh)[:, key_rows]
    vg = v.reshape(B, rows, GRID_W, H, dh)[:, key_rows]
    s = jnp.einsum('brqhd,brakhd->brhqak', qg, kg).astype(jnp.float32) * (dh ** -0.5)
    dr_idx = key_rows - r[:, None] + (NA_WIN_ROWS - 1)
    dc = c[None, :] - c[:, None]
    dc_idx = jnp.clip(dc + NA_WIN_COLS - 1, 0, 2 * NA_WIN_COLS - 2)
    in_win = (c[None, :] >= cs[:, None]) & (c[None, :] < cs[:, None] + NA_WIN_COLS)
    bias = rpb.astype(jnp.float32)[:, dr_idx[:, None, :, None], dc_idx[None, :, None, :]]
    bias = jnp.where(in_win[:, None, :], jnp.transpose(bias, (1, 0, 2, 3, 4)), -jnp.inf)
    p = jax.nn.softmax(s + bias[None], axis=(-2, -1))
    o = jnp.einsum('brhqak,brakhd->brqhd', p.astype(v.dtype), vg)
    return o.reshape(B, S, H * dh)


def sliding_window_gqa(q, k, v, sink):
    B, S, Hq, dh = q.shape
    Hkv = k.shape[2]
    G = Hq // Hkv
    nb = S // SWA_BLOCK
    pad = ((0, 0), (SWA_BLOCK, SWA_BLOCK), (0, 0), (0, 0))
    kp = jnp.pad(k, pad).reshape(B, nb + 2, SWA_BLOCK, Hkv, dh)
    vp = jnp.pad(v, pad).reshape(B, nb + 2, SWA_BLOCK, Hkv, dh)
    kw = jnp.concatenate([kp[:, :-2], kp[:, 1:-1], kp[:, 2:]], axis=2)
    vw = jnp.concatenate([vp[:, :-2], vp[:, 1:-1], vp[:, 2:]], axis=2)
    qb = q.reshape(B, nb, SWA_BLOCK, Hkv, G, dh)
    s = jnp.einsum('bnqkgd,bnckd->bnkgqc', qb, kw).astype(jnp.float32) * (dh ** -0.5)
    blk = jnp.arange(nb)[:, None]
    qpos = blk * SWA_BLOCK + jnp.arange(SWA_BLOCK)[None, :]
    kpos = (blk - 1) * SWA_BLOCK + jnp.arange(3 * SWA_BLOCK)[None, :]
    valid = ((kpos >= 0) & (kpos < S))[:, None, :] & \
        (jnp.abs(qpos[:, :, None] - kpos[:, None, :]) <= SWA_WINDOW)
    s = jnp.where(valid[None, :, None, None], s, -jnp.inf)
    sink_l = jnp.broadcast_to(sink.astype(jnp.float32).reshape(Hkv, G)[None, None, :, :, None, None],
                              s.shape[:-1] + (1,))
    p = jax.nn.softmax(jnp.concatenate([s, sink_l], axis=-1), axis=-1)[..., :-1]
    o = jnp.einsum('bnkgqc,bnckd->bnqkgd', p.astype(v.dtype), vw)
    return o.reshape(B, S, Hq * dh)


def token_mixer(h, w_in, gate_bias, qk_norm, na_rpb, swa_sink, w_branch_na, w_branch_swa, w_out, pos):
    B, S, _ = h.shape
    proj = h @ w_in
    qa, ka, va, qb, kb, vb, gl = jnp.split(proj, IN_SPLITS, axis=-1)
    heads = lambda t, n: t.reshape(B, S, n, HEAD_DIM)
    qa = rms_norm(heads(qa, NA_HEADS), qk_norm[0])
    ka = rms_norm(heads(ka, NA_HEADS), qk_norm[1])
    va = heads(va, NA_HEADS)
    qb = rotary(rms_norm(heads(qb, GQA_Q_HEADS), qk_norm[2]), pos)
    kb = rotary(rms_norm(heads(kb, GQA_KV_HEADS), qk_norm[3]), pos)
    vb = heads(vb, GQA_KV_HEADS)
    oa = neighbourhood_attention(qa, ka, va, na_rpb)
    ob = sliding_window_gqa(qb, kb, vb, swa_sink)
    gates = jax.nn.sigmoid((gl.reshape(B, S, N_BRANCH, D_MODEL) + gate_bias).astype(jnp.float32)).astype(h.dtype)
    merged = gates[:, :, 0] * (oa @ w_branch_na) + gates[:, :, 1] * (ob @ w_branch_swa)
    return merged @ w_out


def peer_ffn(x, w_query, sub_keys, expert_down, expert_up):
    B, S, D = x.shape
    T = B * S
    half = PEER_KEY_DIM // 2

    def chunk(xc):
        q = (xc @ w_query).reshape(PEER_CHUNK, PEER_HEADS, 2, half)
        s = jnp.einsum('thpk,pnk->thpn', q, sub_keys).astype(jnp.float32)
        sv, si = lax.top_k(s, PEER_TOPK)
        cand = (sv[:, :, 0, :, None] + sv[:, :, 1, None, :]).reshape(PEER_CHUNK, PEER_HEADS, PEER_TOPK * PEER_TOPK)
        cidx = (si[:, :, 0, :, None] * PEER_N_KEYS + si[:, :, 1, None, :]).reshape(PEER_CHUNK, PEER_HEADS, PEER_TOPK * PEER_TOPK)
        top_s, sel = lax.top_k(cand, PEER_TOPK)
        eidx = jnp.take_along_axis(cidx, sel, axis=-1)
        g = jax.nn.softmax(top_s, axis=-1)
        u = expert_down[eidx]
        vv = expert_up[eidx]
        act = jax.nn.gelu(jnp.einsum('td,thkd->thk', xc, u).astype(jnp.float32), approximate=False)
        return jnp.einsum('thk,thkd->td', (g * act).astype(x.dtype), vv)

    out = lax.map(chunk, x.reshape(T // PEER_CHUNK, PEER_CHUNK, D))
    return out.reshape(B, S, D)


def setup_inputs(seed: int = 0) -> dict:
    key = jax.random.key(seed)
    ks = jax.random.split(key, 16)
    f32 = jnp.float32

    def nrm(k, shape, scale):
        return jax.random.normal(k, shape, f32) * scale

    return {
        "x": nrm(ks[0], (BATCH, SEQ, D_MODEL), 1.0),
        "norm_mix": 1.0 + nrm(ks[1], (DEPTH, D_MODEL), 0.02),
        "w_in": nrm(ks[2], (DEPTH, D_MODEL, IN_COLS), D_MODEL ** -0.5),
        "gate_bias": nrm(ks[3], (DEPTH, N_BRANCH, D_MODEL), 0.02),
        "qk_norm": 1.0 + nrm(ks[4], (DEPTH, 4, HEAD_DIM), 0.02),
        "na_rpb": nrm(ks[5], (DEPTH, NA_HEADS, 2 * NA_WIN_ROWS - 1, 2 * NA_WIN_COLS - 1), 0.1),
        "swa_sink": nrm(ks[6], (DEPTH, GQA_Q_HEADS), 0.5),
        "w_branch_na": nrm(ks[7], (DEPTH, NA_WIDTH, D_MODEL), NA_WIDTH ** -0.5),
        "w_branch_swa": nrm(ks[8], (DEPTH, GQA_Q_WIDTH, D_MODEL), GQA_Q_WIDTH ** -0.5),
        "w_out": nrm(ks[9], (DEPTH, D_MODEL, D_MODEL), D_MODEL ** -0.5),
        "norm_ffn": 1.0 + nrm(ks[10], (DEPTH, D_MODEL), 0.02),
        "peer_query": nrm(ks[11], (DEPTH, D_MODEL, PEER_HEADS * PEER_KEY_DIM), D_MODEL ** -0.5),
        "peer_sub_keys": nrm(ks[12], (DEPTH, 2, PEER_N_KEYS, PEER_KEY_DIM // 2), (PEER_KEY_DIM // 2) ** -0.5),
        "peer_down": nrm(ks[13], (DEPTH, PEER_N_EXPERTS, D_MODEL), D_MODEL ** -0.5),
        "peer_up": nrm(ks[14], (DEPTH, PEER_N_EXPERTS, D_MODEL), (PEER_HEADS * PEER_TOPK) ** -0.5),
    }


def reference(x, norm_mix, w_in, gate_bias, qk_norm, na_rpb, swa_sink, w_branch_na, w_branch_swa,
              w_out, norm_ffn, peer_query, peer_sub_keys, peer_down, peer_up):
    S = x.shape[1]
    pos = jnp.arange(S, dtype=jnp.int32)
    for l in range(DEPTH):
        x = x + token_mixer(rms_norm(x, norm_mix[l]), w_in[l], gate_bias[l], qk_norm[l], na_rpb[l],
                            swa_sink[l], w_branch_na[l], w_branch_swa[l], w_out[l], pos)
        x = x + peer_ffn(rms_norm(x, norm_ffn[l]), peer_query[l], peer_sub_keys[l], peer_down[l], peer_up[l])
    return x
```

```cpp
#include <hip/hip_runtime.h>
#include <hip/hip_cooperative_groups.h>
#include <cstdio>
namespace cg = cooperative_groups;

typedef unsigned short u16;
typedef __attribute__((ext_vector_type(8))) short bf16x8;
typedef __attribute__((ext_vector_type(16))) float f32x16;
typedef __attribute__((ext_vector_type(2))) __bf16 bf2_t;
typedef __attribute__((ext_vector_type(2))) float f2_t;
typedef __attribute__((ext_vector_type(4))) unsigned u32x4;
#define DI __device__ __forceinline__
#define MFMA(a, b, c) __builtin_amdgcn_mfma_f32_32x32x16_bf16((a), (b), (c), 0, 0, 0)

constexpr int T_ = 16384, D_ = 1024, S_ = 2048, NC_ = 4352;
constexpr float EPS_ = 1e-6f;

constexpr size_t SZ_WIN = (size_t)NC_ * D_ * 2;
constexpr size_t SZ_WBR = (size_t)1024 * 512 * 2;
constexpr size_t SZ_WOUT = (size_t)1024 * 1024 * 2;
constexpr size_t SZ_WQ = (size_t)2048 * 1024 * 2;
constexpr size_t SZ_SK = (size_t)2 * 128 * 128 * 2;
constexpr size_t SZ_PE = (size_t)16384 * 1024 * 2;
constexpr size_t OFF_WIN = 0;
constexpr size_t OFF_WNA = OFF_WIN + 2 * SZ_WIN;
constexpr size_t OFF_WSWA = OFF_WNA + 2 * SZ_WBR;
constexpr size_t OFF_WOUT = OFF_WSWA + 2 * SZ_WBR;
constexpr size_t OFF_WQ = OFF_WOUT + 2 * SZ_WOUT;
constexpr size_t OFF_SK = OFF_WQ + 2 * SZ_WQ;
constexpr size_t OFF_PD = OFF_SK + 2 * SZ_SK;
constexpr size_t OFF_PU = OFF_PD + 2 * SZ_PE;
constexpr size_t OFF_XB = OFF_PU + 2 * SZ_PE;
constexpr size_t OFF_PROJ = OFF_XB + (size_t)T_ * D_ * 2;
constexpr size_t OFF_VT = OFF_PROJ + (size_t)T_ * NC_ * 2;
constexpr size_t OFF_OAB = OFF_VT + (size_t)8 * 10 * 64 * 2048 * 2;
constexpr size_t OFF_MERGED = OFF_OAB + (size_t)T_ * D_ * 2;
constexpr size_t OFF_RIDX = OFF_MERGED + (size_t)T_ * D_ * 2;
constexpr size_t OFF_RG = OFF_RIDX + (size_t)T_ * 128 * 4;
constexpr size_t OFF_RSSP = OFF_RG + (size_t)T_ * 128 * 4;
constexpr size_t OFF_ROPE = OFF_RSSP + (size_t)T_ * 8 * 4;
constexpr size_t OFF_BAR = OFF_ROPE + (size_t)2 * 2048 * 32 * 4;
constexpr size_t WS_TOTAL = OFF_BAR + 16384;
constexpr size_t OFF_PQ = OFF_PROJ;

struct Params {
  const float* x; const float* norm_mix; const float* w_in; const float* gate_bias; const float* qk_norm;
  const float* na_rpb; const float* swa_sink; const float* w_bna; const float* w_bswa; const float* w_out;
  const float* norm_ffn; const float* peer_query; const float* peer_sub; const float* peer_down; const float* peer_up;
  float* out; char* ws;
  int ph_lo, ph_hi;
  int rep_mask, pad_;
};

DI unsigned pack2(float a, float b) { f2_t v = {a, b}; bf2_t r = __builtin_convertvector(v, bf2_t); return __builtin_bit_cast(unsigned, r); }
DI float bflo(unsigned u) { return __uint_as_float(u << 16); }
DI float bfhi(unsigned u) { return __uint_as_float(u & 0xffff0000u); }
DI uint4 pack8(const float* v) { return make_uint4(pack2(v[0], v[1]), pack2(v[2], v[3]), pack2(v[4], v[5]), pack2(v[6], v[7])); }
DI int lane_id() { return (int)__builtin_amdgcn_mbcnt_hi(~0u, __builtin_amdgcn_mbcnt_lo(~0u, 0u)); }
DI int ltid(const int wv) { int t = (wv << 6) | lane_id(); asm volatile("" : "+v"(t)); return t; }
DI char* lws(const Params& p) { size_t z = 0; asm volatile("" : "+s"(z)); return p.ws + z; }
DI float wsum(float v) {
#pragma unroll
  for (int o = 32; o > 0; o >>= 1) v += __shfl_xor(v, o);
  return v;
}
DI float xsum32(float a, float b) { auto s = __builtin_amdgcn_permlane32_swap(__float_as_uint(a), __float_as_uint(b), false, false); return __uint_as_float(s[0]) + __uint_as_float(s[1]); }
DI float xsum16(float a, float b) { auto s = __builtin_amdgcn_permlane16_swap(__float_as_uint(a), __float_as_uint(b), false, false); return __uint_as_float(s[0]) + __uint_as_float(s[1]); }
template <int CTRL> DI float dppf(float x) { return __builtin_bit_cast(float, __builtin_amdgcn_mov_dpp(__builtin_bit_cast(int, x), CTRL, 0xf, 0xf, true)); }
DI float wsum_valu(float v) {
  v += dppf<0xB1>(v); v += dppf<0x4E>(v); v += dppf<0x124>(v); v += dppf<0x128>(v);
  v = xsum16(v, v);
  return xsum32(v, v);
}

DI void transpose_tile(const float* __restrict__ W, int K, int N, const float* __restrict__ scale, u16* __restrict__ Wt,
                       int kt, int nt, float* sm, const int tid) {
  __syncthreads();
#pragma unroll
  for (int i = 0; i < 2; ++i) {
    int k = (tid >> 4) + 32 * i; int n4 = (tid & 15) * 4;
    float4 v = *(const float4*)(W + (size_t)(kt * 64 + k) * N + nt * 64 + n4);
    float sc = scale ? scale[kt * 64 + k] : 1.f;
    float* d = sm + k * 65 + n4;
    d[0] = v.x * sc; d[1] = v.y * sc; d[2] = v.z * sc; d[3] = v.w * sc;
  }
  __syncthreads();
  {
    int n = (tid >> 3); int c = tid & 7;
    unsigned o[4];
#pragma unroll
    for (int j = 0; j < 4; ++j) o[j] = pack2(sm[(c * 8 + 2 * j) * 65 + n], sm[(c * 8 + 2 * j + 1) * 65 + n]);
    *(uint4*)(Wt + (size_t)(nt * 64 + n) * K + kt * 64 + c * 8) = make_uint4(o[0], o[1], o[2], o[3]);
  }
}

DI void convert_rows(const float* __restrict__ src, u16* __restrict__ dst, size_t n8, const float* __restrict__ colscale, const int tid) {
  const size_t gtid = (size_t)blockIdx.x * 512 + tid, gsz = (size_t)gridDim.x * 512;
  for (size_t i = gtid; i < n8; i += gsz) {
    size_t e = i * 8;
    float4 a = *(const float4*)(src + e), b = *(const float4*)(src + e + 4);
    float v[8] = {a.x, a.y, a.z, a.w, b.x, b.y, b.z, b.w};
    if (colscale) {
      int c = (int)(e & 1023);
      float4 s0 = *(const float4*)(colscale + c), s1 = *(const float4*)(colscale + c + 4);
      v[0] *= s0.x; v[1] *= s0.y; v[2] *= s0.z; v[3] *= s0.w; v[4] *= s1.x; v[5] *= s1.y; v[6] *= s1.z; v[7] *= s1.w;
    }
    *(uint4*)(dst + e) = pack8(v);
  }
}

constexpr float PD_SCALE = 64.f, PU_SCALE = 16.f;
DI void convert_rows_fp8(const float* __restrict__ src, unsigned char* __restrict__ dst, size_t n16, const float* __restrict__ colscale, float scale, const int tid,
                         const int blk, const int nblk) {
  const size_t gtid = (size_t)blk * 512 + tid, gsz = (size_t)nblk * 512;
  for (size_t i = gtid; i < n16; i += gsz) {
    size_t e = i * 16;
    unsigned w[4];
#pragma unroll
    for (int q = 0; q < 4; ++q) {
      float4 a = *(const float4*)(src + e + 4 * q);
      float4 sc = make_float4(scale, scale, scale, scale);
      if (colscale) { float4 c = *(const float4*)(colscale + ((e + 4 * q) & 1023)); sc.x *= c.x; sc.y *= c.y; sc.z *= c.z; sc.w *= c.w; }
      int v = 0;
      v = __builtin_amdgcn_cvt_pk_fp8_f32(a.x * sc.x, a.y * sc.y, v, false);
      v = __builtin_amdgcn_cvt_pk_fp8_f32(a.z * sc.z, a.w * sc.w, v, true);
      w[q] = (unsigned)v;
    }
    const size_t row = i >> 6; const int c16 = (int)(i & 63);
    *(uint4*)(dst + ((size_t)(c16 >> 3) * 16384 + row) * 128 + (c16 & 7) * 16) = make_uint4(w[0], w[1], w[2], w[3]);
  }
}

DI void phase_prep(const Params& p, char* smem, const int wv) {
  float* sm = (float*)smem;
  const int tid = ltid(wv);
  char* const ws = lws(p);
  constexpr int NT_L = 1088 + 128 + 128 + 256 + 512;
  for (int it = blockIdx.x; it < 2 * NT_L; it += gridDim.x) {
    int l = it / NT_L, r = it % NT_L;
    const float* W; const float* sc = nullptr; u16* Wt; int K, N;
    if (r < 1088) { W = p.w_in + (size_t)l * 1024 * NC_; sc = p.norm_mix + l * 1024; Wt = (u16*)(ws + OFF_WIN + l * SZ_WIN); K = 1024; N = NC_; }
    else if (r < 1216) { r -= 1088; W = p.w_bna + (size_t)l * 512 * 1024; Wt = (u16*)(ws + OFF_WNA + l * SZ_WBR); K = 512; N = 1024; }
    else if (r < 1344) { r -= 1216; W = p.w_bswa + (size_t)l * 512 * 1024; Wt = (u16*)(ws + OFF_WSWA + l * SZ_WBR); K = 512; N = 1024; }
    else if (r < 1600) { r -= 1344; W = p.w_out + (size_t)l * 1024 * 1024; Wt = (u16*)(ws + OFF_WOUT + l * SZ_WOUT); K = 1024; N = 1024; }
    else { r -= 1600; W = p.peer_query + (size_t)l * 1024 * 2048; sc = p.norm_ffn + l * 1024; Wt = (u16*)(ws + OFF_WQ + l * SZ_WQ); K = 1024; N = 2048; }
    int ntn = N / 64; int kt = r / ntn, nt = r % ntn;
    transpose_tile(W, K, N, sc, Wt, kt, nt, sm, tid);
  }
  for (int l = 0; l < 2; ++l) {
    if (l == 0) {
      convert_rows_fp8(p.peer_down, (unsigned char*)(ws + OFF_PD), (size_t)16384 * 1024 / 16, p.norm_ffn, PD_SCALE, tid, blockIdx.x, gridDim.x);
      convert_rows_fp8(p.peer_up, (unsigned char*)(ws + OFF_PU), (size_t)16384 * 1024 / 16, nullptr, PU_SCALE, tid, blockIdx.x, gridDim.x);
    }
    convert_rows(p.peer_sub + (size_t)l * 32768, (u16*)(ws + OFF_SK + l * SZ_SK), (size_t)32768 / 8, nullptr, tid);
  }
  {
    const int lane = tid & 63, wave = tid >> 6;
    u16* xb = (u16*)(ws + OFF_XB); float* rssp = (float*)(ws + OFF_RSSP);
    for (int t = blockIdx.x * 8 + wave; t < T_; t += gridDim.x * 8) {
      const float* xr = p.x + (size_t)t * 1024;
      float ss = 0.f;
#pragma unroll
      for (int hh = 0; hh < 2; ++hh) {
        int e = hh * 512 + lane * 8;
        float4 a = *(const float4*)(xr + e), b = *(const float4*)(xr + e + 4);
        float v[8] = {a.x, a.y, a.z, a.w, b.x, b.y, b.z, b.w};
#pragma unroll
        for (int j = 0; j < 8; ++j) ss += v[j] * v[j];
        *(uint4*)(xb + (size_t)t * 1024 + e) = pack8(v);
      }
      ss = wsum(ss);
      if (lane < 8) rssp[t * 8 + lane] = (lane == 0) ? ss : 0.f;
    }
  }
  {
    float* rc = (float*)(ws + OFF_ROPE); float* rsn = rc + 2048 * 32;
    for (int i = blockIdx.x * 512 + tid; i < 2048 * 32; i += gridDim.x * 512) {
      int pos = i >> 5, f = i & 31;
      float inv = exp2f(-(float)f * (13.287712379549449f / 32.f));
      float ang = (float)pos * inv;
      double rev = (double)ang * 0.15915494309189535; rev -= floor(rev);
      float fr = (float)rev;
      rc[i] = __builtin_amdgcn_cosf(fr); rsn[i] = __builtin_amdgcn_sinf(fr);
    }
  }
}

typedef __attribute__((address_space(3))) char lds_char;
constexpr int STAGE_B = 65536;
DI void gemm_main(f32x16 (&acc)[4][2], const u16* __restrict__ A, int lda, const u16* __restrict__ Bt, int ldb, int K,
                  int m0, int n0, u16* sm16, const int tid) {
  char* sm = (char*)sm16;
  const int lane = tid & 63, wave = tid >> 6, wm = wave >> 2, wn = wave & 3;
  const int l32 = lane & 31, h = lane >> 5;
  const int r_in = lane >> 3, ce = (lane & 7) ^ (r_in >> 1);
  const unsigned aoff_e = (unsigned)((r_in * lda + ce * 8) * 2), aoff_o = (unsigned)((r_in * lda + (ce ^ 4) * 8) * 2);
  const unsigned boff_e = (unsigned)((r_in * ldb + ce * 8) * 2), boff_o = (unsigned)((r_in * ldb + (ce ^ 4) * 8) * 2);
  const u16* Ab = A + (size_t)m0 * lda; const u16* Bb = Bt + (size_t)n0 * ldb;
  const int wv = __builtin_amdgcn_readfirstlane(wave);
  const u16* Aw = Ab + (size_t)(wv * 32) * lda; const u16* Bw = Bb + (size_t)(wv * 32) * ldb;
  const unsigned lds0 = (unsigned)__builtin_amdgcn_readfirstlane((int)(unsigned)(size_t)sm);
#define GLDS(voff_, base_, ldsa_) asm volatile("s_mov_b32 m0, %2\n\tglobal_load_lds_dwordx4 %0, %1" :: "v"(voff_), "s"(base_), "s"(ldsa_) : "memory");
#define ISSUE(st, k0) { const unsigned sa_ = lds0 + (unsigned)((st) * STAGE_B) + (unsigned)(wv * 4096); const unsigned sb_ = sa_ + 32768u;  \
    GLDS(aoff_e, Aw + (k0), sa_) GLDS(aoff_o, Aw + (size_t)8 * lda + (k0), sa_ + 1024u)                                                  \
    GLDS(aoff_e, Aw + (size_t)16 * lda + (k0), sa_ + 2048u) GLDS(aoff_o, Aw + (size_t)24 * lda + (k0), sa_ + 3072u)                       \
    GLDS(boff_e, Bw + (k0), sb_) GLDS(boff_o, Bw + (size_t)8 * ldb + (k0), sb_ + 1024u)                                                  \
    GLDS(boff_e, Bw + (size_t)16 * ldb + (k0), sb_ + 2048u) GLDS(boff_o, Bw + (size_t)24 * ldb + (k0), sb_ + 3072u) }
  const int sw = (l32 >> 1) & 7;
  const int rdA = (wm * 128 + l32) * 128, rdB = 32768 + (wn * 64 + l32) * 128;
  __syncthreads();
  ISSUE(0, 0)
  const int KT = K >> 6;
#pragma unroll 1
  for (int kt = 0; kt < KT; ++kt) {
    __builtin_amdgcn_s_waitcnt(0x0F70);
    asm volatile("" ::: "memory");
    __builtin_amdgcn_s_barrier();
    asm volatile("" ::: "memory");
    const char* st = sm + (kt & 1) * STAGE_B;
    bf16x8 fa[2][4], fb[2][2];
#define LDFR(buf, ks_) { const int co_ = (((ks_) * 2 + h) ^ sw) * 16;                                             \
      _Pragma("unroll") for (int mi = 0; mi < 4; ++mi) fa[buf][mi] = *(const bf16x8*)(st + rdA + mi * 4096 + co_);  \
      _Pragma("unroll") for (int ni = 0; ni < 2; ++ni) fb[buf][ni] = *(const bf16x8*)(st + rdB + ni * 4096 + co_); }
    LDFR(0, 0)
    if (kt + 1 < KT) { const int k0 = (kt + 1) * 64; ISSUE((kt + 1) & 1, k0) }
#pragma unroll
    for (int ks = 0; ks < 4; ++ks) {
      if (ks < 3) LDFR((ks + 1) & 1, ks + 1)
#pragma unroll
      for (int mi = 0; mi < 4; ++mi)
#pragma unroll
        for (int ni = 0; ni < 2; ++ni) acc[mi][ni] = MFMA(fb[ks & 1][ni], fa[ks & 1][mi], acc[mi][ni]);
    }
#undef LDFR
#pragma unroll
    for (int ks_ = 0; ks_ < 3; ++ks_) {
#pragma unroll
      for (int r_ = 0; r_ < 6; ++r_) { __builtin_amdgcn_sched_group_barrier(0x008, 1, 0); __builtin_amdgcn_sched_group_barrier(0x100, 1, 0); }
      __builtin_amdgcn_sched_group_barrier(0x008, 2, 0);
    }
    __builtin_amdgcn_sched_group_barrier(0x008, 8, 0);
  }
  __syncthreads();
#undef ISSUE
#undef GLDS
}

constexpr int LDC = 260;
DI void acc_zero(f32x16 (&acc)[4][2]) {
#pragma unroll
  for (int a = 0; a < 4; ++a)
#pragma unroll
    for (int b = 0; b < 2; ++b)
#pragma unroll
      for (int i = 0; i < 16; ++i) acc[a][b][i] = 0.f;
}
DI float row_rstd(const float* rssp, int row) {
  float4 a = *(const float4*)(rssp + (size_t)row * 8), b = *(const float4*)(rssp + (size_t)row * 8 + 4);
  float s = ((a.x + a.y) + (a.z + a.w)) + ((b.x + b.y) + (b.z + b.w));
  return rsqrtf(s * (1.f / 1024.f) + EPS_);
}
DI void unpack8(uint4 u, float* g) {
  g[0] = bflo(u.x); g[1] = bfhi(u.x); g[2] = bflo(u.y); g[3] = bfhi(u.y); g[4] = bflo(u.z); g[5] = bfhi(u.z); g[6] = bflo(u.w); g[7] = bfhi(u.w);
}
template <class F>
DI void gemm_epilogue(const f32x16 (&acc)[4][2], float* Cs, const float* rssp, int m0, int n0, const int tid_in, F&& quad) {
  int tid = tid_in; asm volatile("" : "+v"(tid));
  const int lane = tid & 63, wave = tid >> 6, wm = wave >> 2, wn = wave & 3;
  const int l32 = lane & 31, h = lane >> 5;
  float* rstd_s = Cs + 128 * LDC;
#pragma unroll 1
  for (int hm = 0; hm < 2; ++hm) {
    __syncthreads();
    if (wm == hm) {
#pragma unroll
      for (int mi = 0; mi < 4; ++mi)
#pragma unroll
        for (int ni = 0; ni < 2; ++ni)
#pragma unroll
          for (int g = 0; g < 4; ++g) {
            const int row = mi * 32 + l32, col = wn * 64 + ni * 32 + 8 * g + 4 * h;
            *(float4*)(Cs + row * LDC + col) = make_float4(acc[mi][ni][4 * g], acc[mi][ni][4 * g + 1], acc[mi][ni][4 * g + 2], acc[mi][ni][4 * g + 3]);
          }
    }
    if (rssp && tid < 128) rstd_s[tid] = row_rstd(rssp, m0 + hm * 128 + tid);
    __syncthreads();
    quad(tid, m0 + hm * 128, n0, Cs);
    quad(tid, m0 + hm * 128, n0 + 128, Cs + 128);
  }
}
#define TILE_MAP(it) const int mt = ((it) & 7) * 8 + (((it) >> 3) & 7), nt = (it) >> 6; const int m0 = mt * 256, n0 = nt * 256;

DI void phase_proj(const Params& p, int l, char* smem, const int wv) {
  const int tid = ltid(wv);
  char* const ws = lws(p);
  const u16* A = (const u16*)(ws + OFF_XB);
  const u16* Bt = (const u16*)(ws + OFF_WIN + l * SZ_WIN);
  u16* proj = (u16*)(ws + OFF_PROJ);
  u16* VT = (u16*)(ws + OFF_VT);
  const float* rssp = (const float*)(ws + OFF_RSSP);
  const float* ropec = (const float*)(ws + OFF_ROPE); const float* ropes = ropec + 2048 * 32;
  float* Cs = (float*)smem; const float* rstd_s = Cs + 128 * LDC;
  for (int it = blockIdx.x; it < 64 * 17; it += gridDim.x) {
    TILE_MAP(it)
    f32x16 acc[4][2]; acc_zero(acc);
    gemm_main(acc, A, 1024, Bt, 1024, 1024, m0, n0, (u16*)smem, tid);
    gemm_epilogue(acc, Cs, rssp, m0, n0, tid, [&](const int tid, int m0q, int n0q, const float* CsQ) {
      const int c8 = (tid & 15) * 8;
      const bool isV = (n0q >= 1024 && n0q < 1536) || (n0q >= 2176 && n0q < 2304);
      if (isV) {
        const int c = tid & 127, tg = tid >> 7;
        const int hh = (n0q < 2048) ? (((n0q - 1024) >> 6) + (c >> 6)) : (8 + (c >> 6));
        const int dim = c & 63; const int b = m0q >> 11, s0 = m0q & 2047;
        u16* dst = VT + ((size_t)(b * 10 + hh) * 64 + dim) * 2048 + s0 + tg * 32;
#pragma unroll
        for (int i = 0; i < 4; ++i) {
          float v[8];
#pragma unroll
          for (int j = 0; j < 8; ++j) { int row = tg * 32 + i * 8 + j; v[j] = CsQ[row * LDC + c] * rstd_s[row]; }
          *(uint4*)(dst + i * 8) = pack8(v);
        }
      } else {
        int type; if (n0q < 512) type = 0; else if (n0q < 1024) type = 1; else if (n0q < 2048) type = 2; else if (n0q < 2176) type = 3; else type = 4;
        const int d0 = c8 & 63;
        float gn[8];
        if (type < 4) {
          const float* qn = p.qk_norm + (l * 4 + type) * 64 + d0;
#pragma unroll
          for (int j = 0; j < 8; ++j) gn[j] = qn[j];
        } else {
          const float* gb = p.gate_bias + l * 2048 + (n0q - 2304) + c8;
#pragma unroll
          for (int j = 0; j < 8; ++j) gn[j] = gb[j];
        }
#pragma unroll 1
        for (int ps = 0; ps < 4; ++ps) {
          const int row = ps * 32 + (tid >> 4);
          float4 t0 = *(const float4*)(CsQ + row * LDC + c8), t1 = *(const float4*)(CsQ + row * LDC + c8 + 4);
          float v[8] = {t0.x, t0.y, t0.z, t0.w, t1.x, t1.y, t1.z, t1.w};
          const float rs = rstd_s[row];
#pragma unroll
          for (int j = 0; j < 8; ++j) v[j] *= rs;
          if (type < 4) {
            float ss = 0.f;
#pragma unroll
            for (int j = 0; j < 8; ++j) ss += v[j] * v[j];
            ss += __shfl_xor(ss, 1); ss += __shfl_xor(ss, 2); ss += __shfl_xor(ss, 4);
            const float r = rsqrtf(ss * (1.f / 64.f) + EPS_);
#pragma unroll
            for (int j = 0; j < 8; ++j) v[j] = v[j] * r * gn[j];
            if (type >= 2) {
              float pv[8];
#pragma unroll
              for (int j = 0; j < 8; ++j) pv[j] = __shfl_xor(v[j], 4);
              const int pos = (m0q + row) & 2047; const int dd = d0 & 31;
              float4 c0 = *(const float4*)(ropec + pos * 32 + dd), c1 = *(const float4*)(ropec + pos * 32 + dd + 4);
              float4 s0 = *(const float4*)(ropes + pos * 32 + dd), s1 = *(const float4*)(ropes + pos * 32 + dd + 4);
              float cc[8] = {c0.x, c0.y, c0.z, c0.w, c1.x, c1.y, c1.z, c1.w};
              float sn[8] = {s0.x, s0.y, s0.z, s0.w, s1.x, s1.y, s1.z, s1.w};
              const bool lo = d0 < 32;
#pragma unroll
              for (int j = 0; j < 8; ++j) v[j] = lo ? (v[j] * cc[j] - pv[j] * sn[j]) : (pv[j] * sn[j] + v[j] * cc[j]);
            }
            if (type == 0 || type == 2) {
#pragma unroll
              for (int j = 0; j < 8; ++j) v[j] *= 0.125f;
            }
          } else {
#pragma unroll
            for (int j = 0; j < 8; ++j) v[j] = __builtin_amdgcn_rcpf(1.f + __expf(-(v[j] + gn[j])));
          }
          *(uint4*)(proj + (size_t)(m0q + row) * NC_ + n0q + c8) = pack8(v);
        }
      }
    });
  }
  if (l == 0) {
    const int G = gridDim.x, ntile = 64 * 17;
    const int last0 = ((ntile - 1) / G) * G;
    const int nbusy = ntile - last0;
    int blk = (int)blockIdx.x - nbusy, nblk = G - nbusy;
    if (nblk <= 0) { blk = blockIdx.x; nblk = G; }
    if (blk >= 0) {
      convert_rows_fp8(p.peer_down + (size_t)16384 * 1024, (unsigned char*)(ws + OFF_PD + SZ_PE), (size_t)16384 * 1024 / 16, p.norm_ffn + 1024, PD_SCALE, tid, blk, nblk);
      convert_rows_fp8(p.peer_up + (size_t)16384 * 1024, (unsigned char*)(ws + OFF_PU + SZ_PE), (size_t)16384 * 1024 / 16, nullptr, PU_SCALE, tid, blk, nblk);
    }
  }
}

DI void phase_merge(const Params& p, int l, char* smem, const int wv) {
  const int tid = ltid(wv);
  char* const ws = lws(p);
  const u16* oab = (const u16*)(ws + OFF_OAB);
  const u16* wna = (const u16*)(ws + OFF_WNA + l * SZ_WBR);
  const u16* wsw = (const u16*)(ws + OFF_WSWA + l * SZ_WBR);
  const u16* proj = (const u16*)(ws + OFF_PROJ);
  u16* merged = (u16*)(ws + OFF_MERGED);
  float* Cs = (float*)smem;
  for (int it = blockIdx.x; it < 64 * 4; it += gridDim.x) {
    TILE_MAP(it)
    f32x16 acc[4][2]; acc_zero(acc);
    gemm_main(acc, oab, 1024, wna, 512, 512, m0, n0, (u16*)smem, tid);
    gemm_epilogue(acc, Cs, nullptr, m0, n0, tid, [&](const int tid, int m0q, int n0q, const float* CsQ) {
      const int c8 = (tid & 15) * 8;
#pragma unroll 1
      for (int ps = 0; ps < 4; ++ps) {
        const int row = ps * 32 + (tid >> 4);
        float4 t0 = *(const float4*)(CsQ + row * LDC + c8), t1 = *(const float4*)(CsQ + row * LDC + c8 + 4);
        float g[8]; unpack8(*(const uint4*)(proj + (size_t)(m0q + row) * NC_ + 2304 + n0q + c8), g);
        float v[8] = {t0.x * g[0], t0.y * g[1], t0.z * g[2], t0.w * g[3], t1.x * g[4], t1.y * g[5], t1.z * g[6], t1.w * g[7]};
        *(uint4*)(merged + (size_t)(m0q + row) * 1024 + n0q + c8) = pack8(v);
      }
    });
    acc_zero(acc);
    gemm_main(acc, oab + 512, 1024, wsw, 512, 512, m0, n0, (u16*)smem, tid);
    gemm_epilogue(acc, Cs, nullptr, m0, n0, tid, [&](const int tid, int m0q, int n0q, const float* CsQ) {
      const int c8 = (tid & 15) * 8;
#pragma unroll 1
      for (int ps = 0; ps < 4; ++ps) {
        const int row = ps * 32 + (tid >> 4);
        float4 t0 = *(const float4*)(CsQ + row * LDC + c8), t1 = *(const float4*)(CsQ + row * LDC + c8 + 4);
        float g[8]; unpack8(*(const uint4*)(proj + (size_t)(m0q + row) * NC_ + 2304 + 1024 + n0q + c8), g);
        u16* mp = merged + (size_t)(m0q + row) * 1024 + n0q + c8;
        float q[8]; unpack8(*(const uint4*)mp, q);
        float v[8] = {q[0] + t0.x * g[0], q[1] + t0.y * g[1], q[2] + t0.z * g[2], q[3] + t0.w * g[3], q[4] + t1.x * g[4], q[5] + t1.y * g[5], q[6] + t1.z * g[6], q[7] + t1.w * g[7]};
        *(uint4*)mp = pack8(v);
      }
    });
  }
}

DI void phase_out(const Params& p, int l, char* smem, const int wv) {
  const int tid = ltid(wv);
  char* const ws = lws(p);
  const u16* merged = (const u16*)(ws + OFF_MERGED);
  const u16* wout = (const u16*)(ws + OFF_WOUT + l * SZ_WOUT);
  u16* xb = (u16*)(ws + OFF_XB); float* rssp = (float*)(ws + OFF_RSSP);
  const float* xold = (l == 0) ? p.x : p.out;
  float* Cs = (float*)smem;
  for (int it = blockIdx.x; it < 64 * 4; it += gridDim.x) {
    TILE_MAP(it)
    f32x16 acc[4][2]; acc_zero(acc);
    gemm_main(acc, merged, 1024, wout, 1024, 1024, m0, n0, (u16*)smem, tid);
    gemm_epilogue(acc, Cs, nullptr, m0, n0, tid, [&](const int tid, int m0q, int n0q, const float* CsQ) {
      const int c8 = (tid & 15) * 8;
#pragma unroll 1
      for (int ps = 0; ps < 4; ++ps) {
        const int row = ps * 32 + (tid >> 4);
        float4 t0 = *(const float4*)(CsQ + row * LDC + c8), t1 = *(const float4*)(CsQ + row * LDC + c8 + 4);
        const size_t o = (size_t)(m0q + row) * 1024 + n0q + c8;
        float4 x0 = *(const float4*)(xold + o), x1 = *(const float4*)(xold + o + 4);
        float v[8] = {x0.x + t0.x, x0.y + t0.y, x0.z + t0.z, x0.w + t0.w, x1.x + t1.x, x1.y + t1.y, x1.z + t1.z, x1.w + t1.w};
        *(float4*)(p.out + o) = make_float4(v[0], v[1], v[2], v[3]);
        *(float4*)(p.out + o + 4) = make_float4(v[4], v[5], v[6], v[7]);
        *(uint4*)(xb + o) = pack8(v);
        float ss = 0.f;
#pragma unroll
        for (int j = 0; j < 8; ++j) ss += v[j] * v[j];
        ss += dppf<0xB1>(ss); ss += dppf<0x4E>(ss); ss += dppf<0x124>(ss); ss += dppf<0x128>(ss);
        if ((tid & 15) == 0) rssp[(size_t)(m0q + row) * 8 + (n0q >> 7)] = ss;
      }
    });
  }
}

DI void phase_pq(const Params& p, int l, char* smem, const int wv) {
  const int tid = ltid(wv);
  char* const ws = lws(p);
  const u16* A = (const u16*)(ws + OFF_XB);
  const u16* Bt = (const u16*)(ws + OFF_WQ + l * SZ_WQ);
  u16* pq = (u16*)(ws + OFF_PQ);
  const float* rssp = (const float*)(ws + OFF_RSSP);
  float* Cs = (float*)smem; const float* rstd_s = Cs + 128 * LDC;
  for (int it = blockIdx.x; it < 64 * 8; it += gridDim.x) {
    TILE_MAP(it)
    f32x16 acc[4][2]; acc_zero(acc);
    gemm_main(acc, A, 1024, Bt, 1024, 1024, m0, n0, (u16*)smem, tid);
    gemm_epilogue(acc, Cs, rssp, m0, n0, tid, [&](const int tid, int m0q, int n0q, const float* CsQ) {
      const int c8 = (tid & 15) * 8;
#pragma unroll 1
      for (int ps = 0; ps < 4; ++ps) {
        const int row = ps * 32 + (tid >> 4);
        float4 t0 = *(const float4*)(CsQ + row * LDC + c8), t1 = *(const float4*)(CsQ + row * LDC + c8 + 4);
        const float rs = rstd_s[row];
        float v[8] = {t0.x * rs, t0.y * rs, t0.z * rs, t0.w * rs, t1.x * rs, t1.y * rs, t1.z * rs, t1.w * rs};
        *(uint4*)(pq + (size_t)(m0q + row) * 2048 + n0q + c8) = pack8(v);
      }
    });
  }
}

constexpr float NEG_ = -1e30f;
DI bf16x8 pack_p(const float* pp) {
  uint4 u = make_uint4(pack2(pp[0], pp[1]), pack2(pp[2], pp[3]), pack2(pp[4], pp[5]), pack2(pp[6], pp[7]));
  return __builtin_bit_cast(bf16x8, u);
}
DI bf16x8 load_vfrag(const u16* vt_row, int key0, int h) {
  uint2 a = *(const uint2*)(vt_row + key0 + 4 * h);
  uint2 b = *(const uint2*)(vt_row + key0 + 8 + 4 * h);
  uint4 u = make_uint4(a.x, a.y, b.x, b.y);
  return __builtin_bit_cast(bf16x8, u);
}

template <bool isNA>
DI void attn_items(const Params& p, int l, char* smem, const int wv) {
  const int tid = ltid(wv), lane = tid & 63, wave = tid >> 6;
  char* const ws = lws(p);
  const int l32 = lane & 31, h = lane >> 5;
  const u16* proj = (const u16*)(ws + OFF_PROJ);
  const u16* VT = (const u16*)(ws + OFF_VT);
  u16* oab = (u16*)(ws + OFF_OAB);
  float* rpb_s = (float*)smem + wave * 480;
  const int gw = blockIdx.x * 8 + wave, nw = gridDim.x * 8;
  for (int item0 = gw; item0 < 4096; item0 += nw) {
    const int item = isNA ? item0 : item0 + 4096;
    int b, hd, tokq0, qcol, kcol, vhead, ocol;
    int rq = 0, cq = 0, cs = 0, rs_q = 0, rs_lo = 0, kcs = 0;
    int q0 = 0, kb_lo = 0, kb_hi = 0;
    int tql;
    float m, lsum;
    if (isNA) {
      const int xj = (item >> 3) & 7, li = ((item >> 6) << 3) | (item & 7);
      const int pair = (li >> 6) * 8 + xj; b = pair >> 3; hd = pair & 7;
      const int r0 = ((li >> 2) & 15) * 2, cg = li & 3;
      rq = r0 + (l32 >> 4); cq = cg * 16 + (l32 & 15);
      cs = min(max(cq - 8, 0), 48); rs_q = min(max(rq - 4, 0), 24);
      rs_lo = min(max(r0 - 4, 0), 24); kcs = min(max(cg * 16 - 8, 0), 32);
      const int rs_hi = min(max(r0 - 3, 0), 24);
      tokq0 = b * 2048 + r0 * 64; tql = b * 2048 + rq * 64 + cq;
      qcol = hd * 64; kcol = 512 + hd * 64; vhead = hd; ocol = hd * 64;
      m = NEG_; lsum = 0.f;
      const float* rp = p.na_rpb + (size_t)(l * 8 + hd) * 465;
      for (int i = lane; i < 465; i += 64) rpb_s[i] = rp[i];
      __threadfence_block();
      kb_lo = 0; kb_hi = rs_hi + 8 - rs_lo;
    } else {
      const int it = item - 4096; const int xj = (it >> 3) & 7, li = ((it >> 6) << 3) | (it & 7);
      const int pair = (li >> 8) * 8 + xj; b = pair >> 1; const int nb = (li >> 4) & 15, qw = li & 3; hd = (pair & 1) * 4 + ((li >> 2) & 3);
      q0 = nb * 128 + qw * 32;
      tokq0 = b * 2048 + q0; tql = tokq0 + l32;
      qcol = 1536 + hd * 64; kcol = 2048 + (hd >> 2) * 64; vhead = 8 + (hd >> 2); ocol = 512 + hd * 64;
      m = p.swa_sink[l * 8 + hd]; lsum = (h == 0) ? 1.f : 0.f;
      kb_lo = max(q0 / 32 - 4, 0); kb_hi = min(q0 / 32 + 5, 64);
    }
    bf16x8 qf[4];
    {
      const u16* qp = proj + (size_t)tql * NC_ + qcol + h * 8;
#pragma unroll
      for (int s = 0; s < 4; ++s) qf[s] = *(const bf16x8*)(qp + s * 16);
    }
    f32x16 o0, o1;
#pragma unroll
    for (int i = 0; i < 16; ++i) { o0[i] = 0.f; o1[i] = 0.f; }
    const u16* vt0 = VT + ((size_t)(b * 10 + vhead) * 64 + l32) * 2048;
    const u16* vt1 = vt0 + (size_t)32 * 2048;
    for (int kb = kb_lo; kb < kb_hi; ++kb) {
      int kpos0;
      const int kr = rs_lo + kb;
      if (isNA) kpos0 = kr * 64 + kcs;
      else kpos0 = kb * 32;
      const u16* kp = proj + (size_t)(b * 2048 + kpos0 + l32) * NC_ + kcol + h * 8;
      bf16x8 kf[4];
#pragma unroll
      for (int s = 0; s < 4; ++s) kf[s] = *(const bf16x8*)(kp + s * 16);
      bf16x8 vf0[2], vf1[2];
#pragma unroll
      for (int s2 = 0; s2 < 2; ++s2) { vf0[s2] = load_vfrag(vt0, kpos0 + 16 * s2, h); vf1[s2] = load_vfrag(vt1, kpos0 + 16 * s2, h); }
      f32x16 sc;
#pragma unroll
      for (int i = 0; i < 16; ++i) sc[i] = 0.f;
#pragma unroll
      for (int s = 0; s < 4; ++s) sc = MFMA(kf[s], qf[s], sc);
      float sv[16]; bool ok[16];
      float bm = NEG_;
      if (isNA) {
        const int drb = min(max(kr - rq + 7, 0), 14) * 31;
        const bool rowok = (kr >= rs_q) && (kr < rs_q + 8);
#pragma unroll
        for (int i = 0; i < 16; ++i) {
          const int kc = kcs + (i & 3) + 8 * (i >> 2) + 4 * h;
          ok[i] = rowok && (kc >= cs) && (kc < cs + 16);
          int dc = min(max(kc - cq + 15, 0), 30);
          sv[i] = sc[i] + rpb_s[drb + dc];
          bm = fmaxf(bm, ok[i] ? sv[i] : NEG_);
        }
      } else {
        const int qpos = q0 + l32;
#pragma unroll
        for (int i = 0; i < 16; ++i) {
          const int kpos = kpos0 + (i & 3) + 8 * (i >> 2) + 4 * h;
          int dlt = qpos - kpos; dlt = dlt < 0 ? -dlt : dlt;
          ok[i] = dlt <= 128;
          sv[i] = sc[i];
          bm = fmaxf(bm, ok[i] ? sv[i] : NEG_);
        }
      }
      { auto sw = __builtin_amdgcn_permlane32_swap(__float_as_uint(bm), __float_as_uint(bm), false, false); bm = fmaxf(__uint_as_float(sw[0]), __uint_as_float(sw[1])); }
      const float mn = fmaxf(m, bm);
      const float alpha = __expf(m - mn);
      m = mn;
      float pp[16]; float psum = 0.f;
#pragma unroll
      for (int i = 0; i < 16; ++i) { pp[i] = ok[i] ? __expf(sv[i] - mn) : 0.f; psum += pp[i]; }
      lsum = lsum * alpha + psum;
#pragma unroll
      for (int i = 0; i < 16; ++i) { o0[i] *= alpha; o1[i] *= alpha; }
#pragma unroll
      for (int s2 = 0; s2 < 2; ++s2) {
        bf16x8 pb = pack_p(pp + 8 * s2);
        o0 = MFMA(vf0[s2], pb, o0);
        o1 = MFMA(vf1[s2], pb, o1);
      }
    }
    const float ltot = xsum32(lsum, lsum);
    const float inv = 1.f / ltot;
    u16* op = oab + (size_t)tql * 1024 + ocol;
#pragma unroll
    for (int g = 0; g < 4; ++g) {
      const int d = 8 * g + 4 * h;
      *(uint2*)(op + d) = make_uint2(pack2(o0[4 * g] * inv, o0[4 * g + 1] * inv), pack2(o0[4 * g + 2] * inv, o0[4 * g + 3] * inv));
      *(uint2*)(op + 32 + d) = make_uint2(pack2(o1[4 * g] * inv, o1[4 * g + 1] * inv), pack2(o1[4 * g + 2] * inv, o1[4 * g + 3] * inv));
    }
  }
}
DI void phase_attn(const Params& p, int l, char* smem, const int wv) {
  attn_items<true>(p, l, smem, wv);
  attn_items<false>(p, l, smem, wv);
}

DI void chain_insert(float (&a)[16], float x) {
#pragma unroll
  for (int j = 15; j >= 1; --j) a[j] = __builtin_amdgcn_fmed3f(a[j - 1], a[j], x);
  a[0] = fmaxf(a[0], x);
}
DI void topk_half(float (&lst)[16], const u16* __restrict__ pq_tok, const u16* __restrict__ sk, int l32, int h) {
  bf16x8 qf[8];
#pragma unroll
  for (int s = 0; s < 8; ++s) qf[s] = *(const bf16x8*)(pq_tok + s * 16 + h * 8);
#pragma unroll
  for (int j = 0; j < 16; ++j) lst[j] = -INFINITY;
#pragma unroll 1
  for (int kb = 0; kb < 4; ++kb) {
    f32x16 sc;
#pragma unroll
    for (int i = 0; i < 16; ++i) sc[i] = 0.f;
    const u16* kp = sk + (size_t)(kb * 32 + l32) * 128 + h * 8;
#pragma unroll
    for (int s = 0; s < 8; ++s) { bf16x8 kf = *(const bf16x8*)(kp + s * 16); sc = MFMA(kf, qf[s], sc); }
#pragma unroll
    for (int i = 0; i < 16; ++i) {
      const unsigned key = kb * 32 + (i & 3) + 8 * (i >> 2) + 4 * h;
      chain_insert(lst, __uint_as_float((__float_as_uint(sc[i]) & 0xFFFFFF80u) | key));
    }
  }
  float oth[16];
#pragma unroll
  for (int j = 0; j < 16; ++j) oth[j] = __shfl_xor(lst[j], 32);
#pragma unroll
  for (int j = 0; j < 16; ++j) chain_insert(lst, oth[j]);
}

DI void route_item(const u16* qrow, const u16* __restrict__ sk, int* __restrict__ ridx, float* __restrict__ rg, const int t, const int hh, const int l32, const int h) {
  float A[16], B[16], C[16];
  topk_half(A, qrow, sk, l32, h);
  topk_half(B, qrow + 128, sk + 128 * 128, l32, h);
#pragma unroll
  for (int j = 0; j < 16; ++j) C[j] = -INFINITY;
#pragma unroll
  for (int i = 0; i < 16; ++i)
#pragma unroll
    for (int j = 0; j < 16; ++j)
      if ((i + 1) * (j + 1) <= 16) {
        float s = A[i] + B[j];
        chain_insert(C, __uint_as_float((__float_as_uint(s) & 0xFFFFFF00u) | (unsigned)(i * 16 + j)));
      }
  const float thr = C[15], mx = C[0];
  float den = 0.f;
#pragma unroll
  for (int j = 0; j < 16; ++j) den += __expf(C[j] - mx);
  const float rden = 1.f / den;
  if (h == 0) {
    int cnt = 0;
    int* ip = ridx + (size_t)t * 128 + hh * 16; float* gp = rg + (size_t)t * 128 + hh * 16;
#pragma unroll
    for (int i = 0; i < 16; ++i)
#pragma unroll
      for (int j = 0; j < 16; ++j)
        if ((i + 1) * (j + 1) <= 16) {
          float s = A[i] + B[j];
          float key = __uint_as_float((__float_as_uint(s) & 0xFFFFFF00u) | (unsigned)(i * 16 + j));
          if (key >= thr && cnt < 16) {
            ip[cnt] = (int)(((__float_as_uint(A[i]) & 127u) << 7) | (__float_as_uint(B[j]) & 127u));
            gp[cnt] = __expf(key - mx) * rden;
            ++cnt;
          }
        }
  }
}

constexpr int QLD = 264;
DI void phase_pqr(const Params& p, int l, char* smem, const int wv) {
  const int tid = ltid(wv);
  char* const ws = lws(p);
  const u16* A = (const u16*)(ws + OFF_XB);
  const u16* Bt = (const u16*)(ws + OFF_WQ + l * SZ_WQ);
  const float* rssp = (const float*)(ws + OFF_RSSP);
  const u16* sk = (const u16*)(ws + OFF_SK + l * SZ_SK);
  int* ridx = (int*)(ws + OFF_RIDX); float* rg = (float*)(ws + OFF_RG);
  u16* qimg = (u16*)smem;
  for (int it = blockIdx.x; it < 64 * 8; it += gridDim.x) {
    TILE_MAP(it)
    f32x16 acc[4][2]; acc_zero(acc);
    gemm_main(acc, A, 1024, Bt, 1024, 1024, m0, n0, (u16*)smem, tid);
    int tq = tid; asm volatile("" : "+v"(tq));
    const int lane = tq & 63, wave = tq >> 6, wm = wave >> 2, wn = wave & 3, l32 = lane & 31, h = lane >> 5;
#pragma unroll
    for (int mi = 0; mi < 4; ++mi) {
      const int row = wm * 128 + mi * 32 + l32;
      const float rs = row_rstd(rssp, m0 + row);
#pragma unroll
      for (int ni = 0; ni < 2; ++ni)
#pragma unroll
        for (int g = 0; g < 4; ++g) {
          const int col = wn * 64 + ni * 32 + 8 * g + 4 * h;
          *(uint2*)(qimg + row * QLD + col) = make_uint2(pack2(acc[mi][ni][4 * g] * rs, acc[mi][ni][4 * g + 1] * rs), pack2(acc[mi][ni][4 * g + 2] * rs, acc[mi][ni][4 * g + 3] * rs));
        }
    }
    __syncthreads();
    route_item(qimg + (wave * 32 + l32) * QLD, sk, ridx, rg, m0 + wave * 32 + l32, nt, l32, h);
  }
}


DI f2_t cvt8(unsigned w, bool hi) { return hi ? __builtin_amdgcn_cvt_pk_f32_fp8((int)w, true) : __builtin_amdgcn_cvt_pk_f32_fp8((int)w, false); }
DI float dot16_fp8(u32x4 u, const f2_t* x) {
  f2_t acc = {0.f, 0.f};
  acc = __builtin_elementwise_fma(cvt8(u.x, false), x[0], acc); acc = __builtin_elementwise_fma(cvt8(u.x, true), x[1], acc);
  acc = __builtin_elementwise_fma(cvt8(u.y, false), x[2], acc); acc = __builtin_elementwise_fma(cvt8(u.y, true), x[3], acc);
  acc = __builtin_elementwise_fma(cvt8(u.z, false), x[4], acc); acc = __builtin_elementwise_fma(cvt8(u.z, true), x[5], acc);
  acc = __builtin_elementwise_fma(cvt8(u.w, false), x[6], acc); acc = __builtin_elementwise_fma(cvt8(u.w, true), x[7], acc);
  return acc.x + acc.y;
}
DI void axpy16_fp8(f2_t* o, u32x4 v, float c) {
  const f2_t cc = {c, c};
  o[0] = __builtin_elementwise_fma(cvt8(v.x, false), cc, o[0]); o[1] = __builtin_elementwise_fma(cvt8(v.x, true), cc, o[1]);
  o[2] = __builtin_elementwise_fma(cvt8(v.y, false), cc, o[2]); o[3] = __builtin_elementwise_fma(cvt8(v.y, true), cc, o[3]);
  o[4] = __builtin_elementwise_fma(cvt8(v.z, false), cc, o[4]); o[5] = __builtin_elementwise_fma(cvt8(v.z, true), cc, o[5]);
  o[6] = __builtin_elementwise_fma(cvt8(v.w, false), cc, o[6]); o[7] = __builtin_elementwise_fma(cvt8(v.w, true), cc, o[7]);
}

constexpr size_t OFF_PDOT = OFF_PROJ + ((size_t)64 << 20);
constexpr size_t OFF_COEF = OFF_PROJ + ((size_t)128 << 20);

#define GD_ISSUE(U, XA, XC, EA, EB, tt)                                                                \
  {                                                                                                    \
    _Pragma("unroll") for (int b = 0; b < 16; ++b) {                                                   \
      const int e_ = __shfl((b < 8) ? EA : EB, (b & 7) * 8 + rg);                                      \
      U[b] = *(const u32x4*)(tab + ((unsigned)e_ * 128u + (unsigned)(c * 16)));                          \
    }                                                                                                  \
    XA = *(const u32x4*)(xb + (size_t)(tt) * 1024 + j * 128 + c * 16);                                 \
    XC = *(const u32x4*)(xb + (size_t)(tt) * 1024 + j * 128 + c * 16 + 8);                             \
  }
#define GD_COMPUTE(U, XA, XC, tt)                                                                      \
  {                                                                                                    \
    f2_t xf[8];                                                                                        \
    xf[0] = f2_t{bflo(XA.x), bfhi(XA.x)}; xf[1] = f2_t{bflo(XA.y), bfhi(XA.y)}; xf[2] = f2_t{bflo(XA.z), bfhi(XA.z)}; xf[3] = f2_t{bflo(XA.w), bfhi(XA.w)}; \
    xf[4] = f2_t{bflo(XC.x), bfhi(XC.x)}; xf[5] = f2_t{bflo(XC.y), bfhi(XC.y)}; xf[6] = f2_t{bflo(XC.z), bfhi(XC.z)}; xf[7] = f2_t{bflo(XC.w), bfhi(XC.w)}; \
    float d[16];                                                                                       \
    _Pragma("unroll") for (int b = 0; b < 16; ++b) d[b] = dot16_fp8(U[b], xf);                         \
    float r8[8], r4[4], r2[2];                                                                         \
      \
    { const bool up = (lane & 4) != 0;                                                                 \
      _Pragma("unroll") for (int k = 0; k < 8; ++k) { float keep = up ? d[8 + k] : d[k]; float send = up ? d[k] : d[8 + k]; r8[k] = keep + dppf<0x141>(send); } } \
    { const bool up = (lane & 2) != 0;                                                                 \
      _Pragma("unroll") for (int k = 0; k < 4; ++k) { float keep = up ? r8[4 + k] : r8[k]; float send = up ? r8[k] : r8[4 + k]; r4[k] = keep + dppf<0x4E>(send); } } \
    { const bool up = (lane & 1) != 0;                                                                 \
      _Pragma("unroll") for (int k = 0; k < 2; ++k) { float keep = up ? r4[2 + k] : r4[k]; float send = up ? r4[k] : r4[2 + k]; r2[k] = keep + dppf<0xB1>(send); } } \
    _Pragma("unroll") for (int k = 0; k < 2; ++k) pdot[((size_t)j * T_ + (tt)) * 128 + (2 * c + k) * 8 + rg] = r2[k]; \
  }
DI void phase_gdot(const Params& p, int l, char* smem, const int wv) {
  const int tid = ltid(wv), lane = tid & 63, wave = tid >> 6;
  char* const ws = lws(p);
  const int j = blockIdx.x & 7;
  const int wl = (blockIdx.x >> 3) * 8 + wave, nwl = (gridDim.x >> 3) * 8;
  const unsigned char* tab = (const unsigned char*)(ws + OFF_PD + l * SZ_PE) + (size_t)j * 16384 * 128;
  const u16* xb = (const u16*)(ws + OFF_XB);
  const int* ridx = (const int*)(ws + OFF_RIDX);
  float* pdot = (float*)(ws + OFF_PDOT);
  const int rg = lane >> 3, c = lane & 7;
  if (wl >= T_) return;
  u32x4 U0[16], U1[16], XA0, XC0, XA1, XC1;
  int eA0 = ridx[(size_t)wl * 128 + lane], eB0 = ridx[(size_t)wl * 128 + 64 + lane];
  int tn = min(wl + nwl, T_ - 1);
  int eA1 = ridx[(size_t)tn * 128 + lane], eB1 = ridx[(size_t)tn * 128 + 64 + lane];
  GD_ISSUE(U0, XA0, XC0, eA0, eB0, wl)
#pragma unroll 1
  for (int t = wl; t < T_; t += 2 * nwl) {
    const int t1 = t + nwl, t2 = t + 2 * nwl, t3 = t + 3 * nwl;
    if (t1 < T_) GD_ISSUE(U1, XA1, XC1, eA1, eB1, t1)
    { const int tq = min(t2, T_ - 1); eA0 = ridx[(size_t)tq * 128 + lane]; eB0 = ridx[(size_t)tq * 128 + 64 + lane]; }
    GD_COMPUTE(U0, XA0, XC0, t)
    if (t1 < T_) {
      if (t2 < T_) GD_ISSUE(U0, XA0, XC0, eA0, eB0, t2)
      { const int tq = min(t3, T_ - 1); eA1 = ridx[(size_t)tq * 128 + lane]; eB1 = ridx[(size_t)tq * 128 + 64 + lane]; }
      GD_COMPUTE(U1, XA1, XC1, t1)
    }
  }
}
#undef GD_ISSUE
#undef GD_COMPUTE

DI void phase_gcoef(const Params& p, int l, char* smem, const int wv) {
  const int tid = ltid(wv), lane = tid & 63, wave = tid >> 6;
  char* const ws = lws(p);
  const float* rssp = (const float*)(ws + OFF_RSSP); const float* rg_ = (const float*)(ws + OFF_RG);
  const float* pdot = (const float*)(ws + OFF_PDOT); float* coef = (float*)(ws + OFF_COEF);
  const int gw = blockIdx.x * 8 + wave, nw = gridDim.x * 8;
  for (int t = gw; t < T_; t += nw) {
    const float rstd = row_rstd(rssp, t) * (1.f / PD_SCALE);
#pragma unroll
    for (int hh = 0; hh < 2; ++hh) {
      const size_t e = (size_t)t * 128 + hh * 64 + lane;
      float dsum = 0.f;
#pragma unroll
      for (int jj = 0; jj < 8; ++jj) dsum += pdot[(size_t)jj * T_ * 128 + e];
      const float av = dsum * rstd;
      const float act = 0.5f * av * (1.f + erff(av * 0.70710678118654752f));
      coef[e] = rg_[e] * act * (1.f / PU_SCALE);
    }
  }
}

#define GA_ISSUE(U, X1, EA, EB, tt)                                                                    \
  {                                                                                                    \
    _Pragma("unroll") for (int b = 0; b < 16; ++b) {                                                   \
      const int e_ = __shfl((b < 8) ? EA : EB, (b & 7) * 8 + rg);                                      \
      U[b] = *(const u32x4*)(tab + ((unsigned)e_ * 128u + (unsigned)(c * 16)));                          \
    }                                                                                                  \
    X1 = *(const float2*)(p.out + (size_t)(tt) * 1024 + j * 128 + c * 16 + rg * 2);                    \
  }
#define GA_COMPUTE(U, X1, CA, CB, tt)                                                                  \
  {                                                                                                    \
    f2_t of[8];                                                                                        \
    _Pragma("unroll") for (int q = 0; q < 8; ++q) of[q] = f2_t{0.f, 0.f};                              \
    _Pragma("unroll") for (int b = 0; b < 16; ++b) {                                                   \
      const float cf_ = __shfl((b < 8) ? CA : CB, (b & 7) * 8 + rg);                                   \
      axpy16_fp8(of, U[b], cf_);                                                                       \
    }                                                                                                  \
    float o[16];                                                                                       \
    _Pragma("unroll") for (int q = 0; q < 8; ++q) { o[2 * q] = of[q].x; o[2 * q + 1] = of[q].y; }      \
    float r8[8], r4[4], r2[2];                                                                         \
    _Pragma("unroll") for (int k = 0; k < 8; ++k) r8[k] = xsum32(o[k], o[8 + k]);                      \
    _Pragma("unroll") for (int k = 0; k < 4; ++k) r4[k] = xsum16(r8[k], r8[4 + k]);                     \
    { const bool up = (lane & 8) != 0;                                                                 \
      _Pragma("unroll") for (int k = 0; k < 2; ++k) { float keep = up ? r4[2 + k] : r4[k]; float send = up ? r4[k] : r4[2 + k]; r2[k] = keep + dppf<0x128>(send); } } \
    const size_t o_ = (size_t)(tt) * 1024 + j * 128 + c * 16 + rg * 2;                                 \
    const float v0 = X1.x + r2[0], v1 = X1.y + r2[1];                                                  \
    *(float2*)(p.out + o_) = make_float2(v0, v1);                                                      \
    *(unsigned*)(xb + o_) = pack2(v0, v1);                                                             \
    const float ss = wsum_valu(v0 * v0 + v1 * v1);                                                     \
    if (lane == 0) rssp[(size_t)(tt) * 8 + j] = ss;                                                    \
  }
DI void phase_gaxpy(const Params& p, int l, char* smem, const int wv) {
  const int tid = ltid(wv), lane = tid & 63, wave = tid >> 6;
  char* const ws = lws(p);
  const int j = blockIdx.x & 7;
  const int wl = (blockIdx.x >> 3) * 8 + wave, nwl = (gridDim.x >> 3) * 8;
  const unsigned char* tab = (const unsigned char*)(ws + OFF_PU + l * SZ_PE) + (size_t)j * 16384 * 128;
  u16* xb = (u16*)(ws + OFF_XB); float* rssp = (float*)(ws + OFF_RSSP);
  const int* ridx = (const int*)(ws + OFF_RIDX); const float* coef = (const float*)(ws + OFF_COEF);
  const int rg = lane >> 3, c = lane & 7;
  if (wl >= T_) return;
  u32x4 U0[16], U1[16]; float2 X10, X11;
  int eA0 = ridx[(size_t)wl * 128 + lane], eB0 = ridx[(size_t)wl * 128 + 64 + lane];
  float cA0 = coef[(size_t)wl * 128 + lane], cB0 = coef[(size_t)wl * 128 + 64 + lane];
  int tn = min(wl + nwl, T_ - 1);
  int eA1 = ridx[(size_t)tn * 128 + lane], eB1 = ridx[(size_t)tn * 128 + 64 + lane];
  float cA1 = coef[(size_t)tn * 128 + lane], cB1 = coef[(size_t)tn * 128 + 64 + lane];
  GA_ISSUE(U0, X10, eA0, eB0, wl)
#pragma unroll 1
  for (int t = wl; t < T_; t += 2 * nwl) {
    const int t1 = t + nwl, t2 = t + 2 * nwl, t3 = t + 3 * nwl;
    if (t1 < T_) GA_ISSUE(U1, X11, eA1, eB1, t1)
    const float cAc = cA0, cBc = cB0;
    { const int tq = min(t2, T_ - 1); eA0 = ridx[(size_t)tq * 128 + lane]; eB0 = ridx[(size_t)tq * 128 + 64 + lane];
      cA0 = coef[(size_t)tq * 128 + lane]; cB0 = coef[(size_t)tq * 128 + 64 + lane]; }
    GA_COMPUTE(U0, X10, cAc, cBc, t)
    if (t1 < T_) {
      if (t2 < T_) GA_ISSUE(U0, X10, eA0, eB0, t2)
      const float cAd = cA1, cBd = cB1;
      { const int tq = min(t3, T_ - 1); eA1 = ridx[(size_t)tq * 128 + lane]; eB1 = ridx[(size_t)tq * 128 + 64 + lane];
        cA1 = coef[(size_t)tq * 128 + lane]; cB1 = coef[(size_t)tq * 128 + 64 + lane]; }
      GA_COMPUTE(U1, X11, cAd, cBd, t1)
    }
  }
}
#undef GA_ISSUE
#undef GA_COMPUTE

#define XB_TMO      128
#define XB_XCNT(j)  (256  + 64 * (j))
#define XB_XSUB(j)  (1280 + 64 * (j))
#define XB_XGEN(j)  (2304 + 64 * (j))
#define XB_TOP      3328
#define XB_TOPGEN   3392
#define XCD_BAR_WORDS 3456
#define XB_SPIN_CAP (1u << 18)
#define LAS __attribute__((address_space(3)))

__device__ __forceinline__ unsigned xb_ld(unsigned* p)              { return __hip_atomic_load(p, __ATOMIC_RELAXED, __HIP_MEMORY_SCOPE_AGENT); }
__device__ __forceinline__ unsigned xb_add(unsigned* p, unsigned v) { return __hip_atomic_fetch_add(p, v, __ATOMIC_RELAXED, __HIP_MEMORY_SCOPE_AGENT); }
__device__ __forceinline__ unsigned xb_xcc_id() { return (unsigned)__builtin_amdgcn_s_getreg((3 << 11) | 20) & 0xFu; }
#define XB_SPIN(cond, bar) do { unsigned _sp = 0; while (cond) { __builtin_amdgcn_s_sleep(1); \
    if ((++_sp & 255u) == 0u) { if (xb_ld(&(bar)[XB_TMO])) break; if (_sp > XB_SPIN_CAP) { atomicAdd(&(bar)[XB_TMO], 1u); break; } } } } while (0)

struct XcdBarrier {
    unsigned* bar; unsigned x;
    volatile LAS unsigned* st;
};

__device__ __forceinline__ XcdBarrier xcd_barrier_post(unsigned* bar, volatile LAS unsigned* st, const bool t0) {
    XcdBarrier b; b.bar = bar; b.x = xb_xcc_id(); b.st = st;
    if (t0) (void)xb_add(&bar[XB_XCNT(b.x)], 1u);
    return b;
}
__device__ __forceinline__ void xcd_barrier_complete(unsigned* bar, unsigned x, unsigned& nloc, unsigned& nx) {
    const unsigned G = gridDim.x * gridDim.y * gridDim.z;
    unsigned sum, cnt, mine, sp = 0u;
    for (;;) {
        sum = 0u; cnt = 0u; mine = 0u;
#pragma unroll
        for (unsigned j = 0; j < 16; ++j) { const unsigned c = xb_ld(&bar[XB_XCNT(j)]); sum += c; cnt += (c > 0u) ? 1u : 0u; mine = (j == x) ? c : mine; }
        if (sum == G) break;
        __builtin_amdgcn_s_sleep(1);
        if ((++sp & 255u) == 0u) { if (xb_ld(&bar[XB_TMO])) break; if (sp > XB_SPIN_CAP) { atomicAdd(&bar[XB_TMO], 1u); break; } }
    }
    nloc = mine > 0u ? mine : 1u; nx = cnt > 0u ? cnt : 1u;
}

__device__ __forceinline__ void xcd_barrier(const XcdBarrier& b, const bool t0) {
    asm volatile("s_waitcnt vmcnt(0)" ::: "memory");
    __syncthreads();
    if (t0) {
        unsigned* bar = b.bar;
        __builtin_amdgcn_s_waitcnt(0);
        unsigned nloc = b.st[0], nx = b.st[1];
        if (nloc == 0u) { xcd_barrier_complete(bar, b.x, nloc, nx); b.st[0] = nloc; b.st[1] = nx; }
        const unsigned old = xb_add(&bar[XB_XSUB(b.x)], 1u);
        const unsigned gen = old / nloc;
        if (old + 1u == (gen + 1u) * nloc) {
            __builtin_amdgcn_fence(__ATOMIC_RELEASE, "agent");
            asm volatile("s_waitcnt vmcnt(0)" ::: "memory");
            const unsigned og = xb_add(&bar[XB_TOP], 1u);
            const unsigned tg = og / nx;
            if (og + 1u == (tg + 1u) * nx) xb_add(&bar[XB_TOPGEN], 1u);
            else XB_SPIN(xb_ld(&bar[XB_TOPGEN]) == tg, bar);
            __builtin_amdgcn_fence(__ATOMIC_ACQUIRE, "agent");
            xb_add(&bar[XB_XGEN(b.x)], 1u);
            asm volatile("s_waitcnt vmcnt(0)" ::: "memory");
        } else {
            XB_SPIN(xb_ld(&bar[XB_XGEN(b.x)]) == gen, bar);
            __builtin_amdgcn_fence(__ATOMIC_ACQUIRE, "agent");
            asm volatile("s_waitcnt vmcnt(0)" ::: "memory");
        }
    }
    __syncthreads();
}


__global__ void __launch_bounds__(512, 2) mega_kernel(Params p) {
  __shared__ __attribute__((aligned(16))) char smem[147456];
  cg::grid_group grid = cg::this_grid();
#ifndef REP_MASK
#define REP_MASK 0
#endif
#define RUN_PHASE(bit, call) { if (REP_MASK & (bit)) { call; GSYNC() } call; }
  __shared__ __attribute__((aligned(16))) unsigned xb_st[4];
  const int wv = __builtin_amdgcn_readfirstlane((int)(threadIdx.x >> 6));
  unsigned* const bar = (unsigned*)(p.ws + OFF_BAR);
  if (threadIdx.x < 4) xb_st[threadIdx.x] = 0u;
  __syncthreads();
  const XcdBarrier xbar = xcd_barrier_post(bar, (volatile LAS unsigned*)xb_st, wv == 0 && lane_id() == 0);
#define GSYNC() xcd_barrier(xbar, wv == 0 && lane_id() == 0);
  if (p.rep_mask == 0x7fffffff) grid.sync();
  phase_prep(p, smem, wv);
  GSYNC()
#define LAYER(l) {\
    RUN_PHASE(2, phase_proj(p, l, smem, wv)) \
    GSYNC() \
    RUN_PHASE(4, phase_attn(p, l, smem, wv)) \
    GSYNC() \
    RUN_PHASE(8, phase_merge(p, l, smem, wv)) \
    GSYNC() \
    phase_out(p, l, smem, wv); \
    GSYNC() \
    RUN_PHASE(32, phase_pqr(p, l, smem, wv)) \
    GSYNC() \
    RUN_PHASE(128, phase_gdot(p, l, smem, wv)) \
    GSYNC() \
    phase_gcoef(p, l, smem, wv); \
    GSYNC() \
    phase_gaxpy(p, l, smem, wv); \
    if (l == 0) GSYNC() \
  }
  LAYER(0)
  LAYER(1)
}

extern "C" void kernel_launch(void* const* d_in, const int* in_sizes, int n_in, void* d_out, int out_size, void* d_ws,
                              size_t ws_size, hipStream_t stream) {
  static int grid_blocks = 0;
  if (!grid_blocks) {
    int dev = 0, cus = 0, per_cu = 0;
    hipGetDevice(&dev);
    hipDeviceGetAttribute(&cus, hipDeviceAttributeMultiprocessorCount, dev);
    hipOccupancyMaxActiveBlocksPerMultiprocessor(&per_cu, mega_kernel, 512, 0);
    if (per_cu > 1) per_cu = 1;
    if (per_cu < 1) per_cu = 1;
    grid_blocks = cus * per_cu;
  }
  if (ws_size < WS_TOTAL) { fprintf(stderr, "workspace too small: %zu < %zu\n", ws_size, (size_t)WS_TOTAL); return; }
  Params p{};
  p.x = (const float*)d_in[0]; p.norm_mix = (const float*)d_in[1]; p.w_in = (const float*)d_in[2];
  p.gate_bias = (const float*)d_in[3]; p.qk_norm = (const float*)d_in[4]; p.na_rpb = (const float*)d_in[5];
  p.swa_sink = (const float*)d_in[6]; p.w_bna = (const float*)d_in[7]; p.w_bswa = (const float*)d_in[8];
  p.w_out = (const float*)d_in[9]; p.norm_ffn = (const float*)d_in[10]; p.peer_query = (const float*)d_in[11];
  p.peer_sub = (const float*)d_in[12]; p.peer_down = (const float*)d_in[13]; p.peer_up = (const float*)d_in[14];
  p.out = (float*)d_out; p.ws = (char*)d_ws;
  p.ph_lo = 0; p.ph_hi = 15;
  p.rep_mask = 0; p.pad_ = 0;
  hipMemsetAsync((char*)d_ws + OFF_BAR, 0, (size_t)XCD_BAR_WORDS * 4, stream);
  void* args[] = {&p};
  hipError_t e = hipLaunchCooperativeKernel((void*)mega_kernel, dim3(grid_blocks), dim3(512), args, 0, stream);
  if (e != hipSuccess) fprintf(stderr, "cooperative launch failed: %s (grid %d)\n", hipGetErrorString(e), grid_blocks);
}
```

```cpp
#include <hip/hip_runtime.h>
#include <hip/hip_cooperative_groups.h>
#include <cstdio>
namespace cg = cooperative_groups;

typedef unsigned short u16;
typedef __attribute__((ext_vector_type(8))) short bf16x8;
typedef __attribute__((ext_vector_type(16))) float f32x16;
typedef __attribute__((ext_vector_type(2))) __bf16 bf2_t;
typedef __attribute__((ext_vector_type(2))) float f2_t;
typedef __attribute__((ext_vector_type(4))) unsigned u32x4;
#define DI __device__ __forceinline__
#define MFMA(a, b, c) __builtin_amdgcn_mfma_f32_32x32x16_bf16((a), (b), (c), 0, 0, 0)

constexpr int T_ = 16384, D_ = 1024, S_ = 2048, NC_ = 4352;
constexpr float EPS_ = 1e-6f;

constexpr size_t SZ_WIN = (size_t)NC_ * D_ * 2;
constexpr size_t SZ_WBR = (size_t)1024 * 512 * 2;
constexpr size_t SZ_WOUT = (size_t)1024 * 1024 * 2;
constexpr size_t SZ_WQ = (size_t)2048 * 1024 * 2;
constexpr size_t SZ_SK = (size_t)2 * 128 * 128 * 2;
constexpr size_t SZ_PE = (size_t)16384 * 1024 * 2;
constexpr size_t OFF_WIN = 0;
constexpr size_t OFF_WNA = OFF_WIN + 2 * SZ_WIN;
constexpr size_t OFF_WSWA = OFF_WNA + 2 * SZ_WBR;
constexpr size_t OFF_WOUT = OFF_WSWA + 2 * SZ_WBR;
constexpr size_t OFF_WQ = OFF_WOUT + 2 * SZ_WOUT;
constexpr size_t OFF_SK = OFF_WQ + 2 * SZ_WQ;
constexpr size_t OFF_PD = OFF_SK + 2 * SZ_SK;
constexpr size_t OFF_PU = OFF_PD + 2 * SZ_PE;
constexpr size_t OFF_XB = OFF_PU + 2 * SZ_PE;
constexpr size_t OFF_PROJ = OFF_XB + (size_t)T_ * D_ * 2;
constexpr size_t OFF_VT = OFF_PROJ + (size_t)T_ * NC_ * 2;
constexpr size_t OFF_OAB = OFF_VT + (size_t)8 * 10 * 64 * 2048 * 2;
constexpr size_t OFF_MERGED = OFF_OAB + (size_t)T_ * D_ * 2;
constexpr size_t OFF_RIDX = OFF_MERGED + (size_t)T_ * D_ * 2;
constexpr size_t OFF_RG = OFF_RIDX + (size_t)T_ * 128 * 4;
constexpr size_t OFF_RSSP = OFF_RG + (size_t)T_ * 128 * 4;
constexpr size_t OFF_ROPE = OFF_RSSP + (size_t)T_ * 8 * 4;
constexpr size_t OFF_BAR = OFF_ROPE + (size_t)2 * 2048 * 32 * 4;
constexpr size_t WS_TOTAL = OFF_BAR + 16384;
constexpr size_t OFF_PQ = OFF_PROJ;

struct Params {
  const float* x; const float* norm_mix; const float* w_in; const float* gate_bias; const float* qk_norm;
  const float* na_rpb; const float* swa_sink; const float* w_bna; const float* w_bswa; const float* w_out;
  const float* norm_ffn; const float* peer_query; const float* peer_sub; const float* peer_down; const float* peer_up;
  float* out; char* ws;
  int ph_lo, ph_hi;
  int rep_mask, pad_;
};

DI unsigned pack2(float a, float b) { f2_t v = {a, b}; bf2_t r = __builtin_convertvector(v, bf2_t); return __builtin_bit_cast(unsigned, r); }
DI float bflo(unsigned u) { return __uint_as_float(u << 16); }
DI float bfhi(unsigned u) { return __uint_as_float(u & 0xffff0000u); }
DI uint4 pack8(const float* v) { return make_uint4(pack2(v[0], v[1]), pack2(v[2], v[3]), pack2(v[4], v[5]), pack2(v[6], v[7])); }
DI int lane_id() { return (int)__builtin_amdgcn_mbcnt_hi(~0u, __builtin_amdgcn_mbcnt_lo(~0u, 0u)); }
DI int ltid(const int wv) { int t = (wv << 6) | lane_id(); asm volatile("" : "+v"(t)); return t; }
DI char* lws(const Params& p) { size_t z = 0; asm volatile("" : "+s"(z)); return p.ws + z; }
DI float wsum(float v) {
#pragma unroll
  for (int o = 32; o > 0; o >>= 1) v += __shfl_xor(v, o);
  return v;
}
DI float xsum32(float a, float b) { auto s = __builtin_amdgcn_permlane32_swap(__float_as_uint(a), __float_as_uint(b), false, false); return __uint_as_float(s[0]) + __uint_as_float(s[1]); }
DI float xsum16(float a, float b) { auto s = __builtin_amdgcn_permlane16_swap(__float_as_uint(a), __float_as_uint(b), false, false); return __uint_as_float(s[0]) + __uint_as_float(s[1]); }
template <int CTRL> DI float dppf(float x) { return __builtin_bit_cast(float, __builtin_amdgcn_mov_dpp(__builtin_bit_cast(int, x), CTRL, 0xf, 0xf, true)); }
DI float wsum_valu(float v) {
  v += dppf<0xB1>(v); v += dppf<0x4E>(v); v += dppf<0x124>(v); v += dppf<0x128>(v);
  v = xsum16(v, v);
  return xsum32(v, v);
}

DI void transpose_tile(const float* __restrict__ W, int K, int N, const float* __restrict__ scale, u16* __restrict__ Wt,
                       int kt, int nt, float* sm, const int tid) {
  __syncthreads();
#pragma unroll
  for (int i = 0; i < 2; ++i) {
    int k = (tid >> 4) + 32 * i; int n4 = (tid & 15) * 4;
    float4 v = *(const float4*)(W + (size_t)(kt * 64 + k) * N + nt * 64 + n4);
    float sc = scale ? scale[kt * 64 + k] : 1.f;
    float* d = sm + k * 65 + n4;
    d[0] = v.x * sc; d[1] = v.y * sc; d[2] = v.z * sc; d[3] = v.w * sc;
  }
  __syncthreads();
  {
    int n = (tid >> 3); int c = tid & 7;
    unsigned o[4];
#pragma unroll
    for (int j = 0; j < 4; ++j) o[j] = pack2(sm[(c * 8 + 2 * j) * 65 + n], sm[(c * 8 + 2 * j + 1) * 65 + n]);
    *(uint4*)(Wt + (size_t)(nt * 64 + n) * K + kt * 64 + c * 8) = make_uint4(o[0], o[1], o[2], o[3]);
  }
}

DI void convert_rows(const float* __restrict__ src, u16* __restrict__ dst, size_t n8, const float* __restrict__ colscale, const int tid) {
  const size_t gtid = (size_t)blockIdx.x * 512 + tid, gsz = (size_t)gridDim.x * 512;
  for (size_t i = gtid; i < n8; i += gsz) {
    size_t e = i * 8;
    float4 a = *(const float4*)(src + e), b = *(const float4*)(src + e + 4);
    float v[8] = {a.x, a.y, a.z, a.w, b.x, b.y, b.z, b.w};
    if (colscale) {
      int c = (int)(e & 1023);
      float4 s0 = *(const float4*)(colscale + c), s1 = *(const float4*)(colscale + c + 4);
      v[0] *= s0.x; v[1] *= s0.y; v[2] *= s0.z; v[3] *= s0.w; v[4] *= s1.x; v[5] *= s1.y; v[6] *= s1.z; v[7] *= s1.w;
    }
    *(uint4*)(dst + e) = pack8(v);
  }
}

constexpr float PD_SCALE = 64.f, PU_SCALE = 16.f;
DI void convert_rows_fp8(const float* __restrict__ src, unsigned char* __restrict__ dst, size_t n16, const float* __restrict__ colscale, float scale, const int tid,
                         const int blk, const int nblk) {
  const size_t gtid = (size_t)blk * 512 + tid, gsz = (size_t)nblk * 512;
  for (size_t i = gtid; i < n16; i += gsz) {
    size_t e = i * 16;
    unsigned w[4];
#pragma unroll
    for (int q = 0; q < 4; ++q) {
      float4 a = *(const float4*)(src + e + 4 * q);
      float4 sc = make_float4(scale, scale, scale, scale);
      if (colscale) { float4 c = *(const float4*)(colscale + ((e + 4 * q) & 1023)); sc.x *= c.x; sc.y *= c.y; sc.z *= c.z; sc.w *= c.w; }
      int v = 0;
      v = __builtin_amdgcn_cvt_pk_fp8_f32(a.x * sc.x, a.y * sc.y, v, false);
      v = __builtin_amdgcn_cvt_pk_fp8_f32(a.z * sc.z, a.w * sc.w, v, true);
      w[q] = (unsigned)v;
    }
    const size_t row = i >> 6; const int c16 = (int)(i & 63);
    *(uint4*)(dst + ((size_t)(c16 >> 3) * 16384 + row) * 128 + (c16 & 7) * 16) = make_uint4(w[0], w[1], w[2], w[3]);
  }
}

DI void phase_prep(const Params& p, char* smem, const int wv) {
  float* sm = (float*)smem;
  const int tid = ltid(wv);
  char* const ws = lws(p);
  constexpr int NT_L = 1088 + 128 + 128 + 256 + 512;
  for (int it = blockIdx.x; it < 2 * NT_L; it += gridDim.x) {
    int l = it / NT_L, r = it % NT_L;
    const float* W; const float* sc = nullptr; u16* Wt; int K, N;
    if (r < 1088) { W = p.w_in + (size_t)l * 1024 * NC_; sc = p.norm_mix + l * 1024; Wt = (u16*)(ws + OFF_WIN + l * SZ_WIN); K = 1024; N = NC_; }
    else if (r < 1216) { r -= 1088; W = p.w_bna + (size_t)l * 512 * 1024; Wt = (u16*)(ws + OFF_WNA + l * SZ_WBR); K = 512; N = 1024; }
    else if (r < 1344) { r -= 1216; W = p.w_bswa + (size_t)l * 512 * 1024; Wt = (u16*)(ws + OFF_WSWA + l * SZ_WBR); K = 512; N = 1024; }
    else if (r < 1600) { r -= 1344; W = p.w_out + (size_t)l * 1024 * 1024; Wt = (u16*)(ws + OFF_WOUT + l * SZ_WOUT); K = 1024; N = 1024; }
    else { r -= 1600; W = p.peer_query + (size_t)l * 1024 * 2048; sc = p.norm_ffn + l * 1024; Wt = (u16*)(ws + OFF_WQ + l * SZ_WQ); K = 1024; N = 2048; }
    int ntn = N / 64; int kt = r / ntn, nt = r % ntn;
    transpose_tile(W, K, N, sc, Wt, kt, nt, sm, tid);
  }
  for (int l = 0; l < 2; ++l) {
    if (l == 0) {
      convert_rows_fp8(p.peer_down, (unsigned char*)(ws + OFF_PD), (size_t)16384 * 1024 / 16, p.norm_ffn, PD_SCALE, tid, blockIdx.x, gridDim.x);
      convert_rows_fp8(p.peer_up, (unsigned char*)(ws + OFF_PU), (size_t)16384 * 1024 / 16, nullptr, PU_SCALE, tid, blockIdx.x, gridDim.x);
    }
    convert_rows(p.peer_sub + (size_t)l * 32768, (u16*)(ws + OFF_SK + l * SZ_SK), (size_t)32768 / 8, nullptr, tid);
  }
  {
    const int lane = tid & 63, wave = tid >> 6;
    u16* xb = (u16*)(ws + OFF_XB); float* rssp = (float*)(ws + OFF_RSSP);
    for (int t = blockIdx.x * 8 + wave; t < T_; t += gridDim.x * 8) {
      const float* xr = p.x + (size_t)t * 1024;
      float ss = 0.f;
#pragma unroll
      for (int hh = 0; hh < 2; ++hh) {
        int e = hh * 512 + lane * 8;
        float4 a = *(const float4*)(xr + e), b = *(const float4*)(xr + e + 4);
        float v[8] = {a.x, a.y, a.z, a.w, b.x, b.y, b.z, b.w};
#pragma unroll
        for (int j = 0; j < 8; ++j) ss += v[j] * v[j];
        *(uint4*)(xb + (size_t)t * 1024 + e) = pack8(v);
      }
      ss = wsum(ss);
      if (lane < 8) rssp[t * 8 + lane] = (lane == 0) ? ss : 0.f;
    }
  }
  {
    float* rc = (float*)(ws + OFF_ROPE); float* rsn = rc + 2048 * 32;
    for (int i = blockIdx.x * 512 + tid; i < 2048 * 32; i += gridDim.x * 512) {
      int pos = i >> 5, f = i & 31;
      float inv = exp2f(-(float)f * (13.287712379549449f / 32.f));
      float ang = (float)pos * inv;
      double rev = (double)ang * 0.15915494309189535; rev -= floor(rev);
      float fr = (float)rev;
      rc[i] = __builtin_amdgcn_cosf(fr); rsn[i] = __builtin_amdgcn_sinf(fr);
    }
  }
}

typedef __attribute__((address_space(3))) char lds_char;
constexpr int STAGE_B = 65536;
DI void gemm_main(f32x16 (&acc)[4][2], const u16* __restrict__ A, int lda, const u16* __restrict__ Bt, int ldb, int K,
                  int m0, int n0, u16* sm16, const int tid) {
  char* sm = (char*)sm16;
  const int lane = tid & 63, wave = tid >> 6, wm = wave >> 2, wn = wave & 3;
  const int l32 = lane & 31, h = lane >> 5;
  const int r_in = lane >> 3, ce = (lane & 7) ^ (r_in >> 1);
  const unsigned aoff_e = (unsigned)((r_in * lda + ce * 8) * 2), aoff_o = (unsigned)((r_in * lda + (ce ^ 4) * 8) * 2);
  const unsigned boff_e = (unsigned)((r_in * ldb + ce * 8) * 2), boff_o = (unsigned)((r_in * ldb + (ce ^ 4) * 8) * 2);
  const u16* Ab = A + (size_t)m0 * lda; const u16* Bb = Bt + (size_t)n0 * ldb;
  const int wv = __builtin_amdgcn_readfirstlane(wave);
  const u16* Aw = Ab + (size_t)(wv * 32) * lda; const u16* Bw = Bb + (size_t)(wv * 32) * ldb;
  const unsigned lds0 = (unsigned)__builtin_amdgcn_readfirstlane((int)(unsigned)(size_t)sm);
#define GLDS(voff_, base_, ldsa_) asm volatile("s_mov_b32 m0, %2\n\tglobal_load_lds_dwordx4 %0, %1" :: "v"(voff_), "s"(base_), "s"(ldsa_) : "memory");
#define ISSUE(st, k0) { const unsigned sa_ = lds0 + (unsigned)((st) * STAGE_B) + (unsigned)(wv * 4096); const unsigned sb_ = sa_ + 32768u;  \
    GLDS(aoff_e, Aw + (k0), sa_) GLDS(aoff_o, Aw + (size_t)8 * lda + (k0), sa_ + 1024u)                                                  \
    GLDS(aoff_e, Aw + (size_t)16 * lda + (k0), sa_ + 2048u) GLDS(aoff_o, Aw + (size_t)24 * lda + (k0), sa_ + 3072u)                       \
    GLDS(boff_e, Bw + (k0), sb_) GLDS(boff_o, Bw + (size_t)8 * ldb + (k0), sb_ + 1024u)                                                  \
    GLDS(boff_e, Bw + (size_t)16 * ldb + (k0), sb_ + 2048u) GLDS(boff_o, Bw + (size_t)24 * ldb + (k0), sb_ + 3072u) }
  const int sw = (l32 >> 1) & 7;
  const int rdA = (wm * 128 + l32) * 128, rdB = 32768 + (wn * 64 + l32) * 128;
  __syncthreads();
  ISSUE(0, 0)
  const int KT = K >> 6;
#pragma unroll 1
  for (int kt = 0; kt < KT; ++kt) {
    __builtin_amdgcn_s_waitcnt(0x0F70);
    asm volatile("" ::: "memory");
    __builtin_amdgcn_s_barrier();
    asm volatile("" ::: "memory");
    if (kt + 1 < KT) { const int k0 = (kt + 1) * 64; ISSUE((kt + 1) & 1, k0) }
    const char* st = sm + (kt & 1) * STAGE_B;
    bf16x8 fa[2][4], fb[2][2];
#define LDFR(buf, ks_) { const int co_ = (((ks_) * 2 + h) ^ sw) * 16;                                             \
      _Pragma("unroll") for (int mi = 0; mi < 4; ++mi) fa[buf][mi] = *(const bf16x8*)(st + rdA + mi * 4096 + co_);  \
      _Pragma("unroll") for (int ni = 0; ni < 2; ++ni) fb[buf][ni] = *(const bf16x8*)(st + rdB + ni * 4096 + co_); }
    LDFR(0, 0)
#pragma unroll
    for (int ks = 0; ks < 4; ++ks) {
      if (ks < 3) LDFR((ks + 1) & 1, ks + 1)
#pragma unroll
      for (int mi = 0; mi < 4; ++mi)
#pragma unroll
        for (int ni = 0; ni < 2; ++ni) acc[mi][ni] = MFMA(fb[ks & 1][ni], fa[ks & 1][mi], acc[mi][ni]);
    }
#undef LDFR
    __builtin_amdgcn_sched_group_barrier(0x100, 6, 0);
#pragma unroll
    for (int ks_ = 0; ks_ < 3; ++ks_) {
#pragma unroll
      for (int r_ = 0; r_ < 6; ++r_) { __builtin_amdgcn_sched_group_barrier(0x008, 1, 0); __builtin_amdgcn_sched_group_barrier(0x100, 1, 0); }
      __builtin_amdgcn_sched_group_barrier(0x008, 2, 0);
    }
    __builtin_amdgcn_sched_group_barrier(0x008, 8, 0);
  }
  __syncthreads();
#undef ISSUE
#undef GLDS
}

constexpr int LDC = 260;
DI void acc_zero(f32x16 (&acc)[4][2]) {
#pragma unroll
  for (int a = 0; a < 4; ++a)
#pragma unroll
    for (int b = 0; b < 2; ++b)
#pragma unroll
      for (int i = 0; i < 16; ++i) acc[a][b][i] = 0.f;
}
DI float row_rstd(const float* rssp, int row) {
  float4 a = *(const float4*)(rssp + (size_t)row * 8), b = *(const float4*)(rssp + (size_t)row * 8 + 4);
  float s = ((a.x + a.y) + (a.z + a.w)) + ((b.x + b.y) + (b.z + b.w));
  return rsqrtf(s * (1.f / 1024.f) + EPS_);
}
DI void unpack8(uint4 u, float* g) {
  g[0] = bflo(u.x); g[1] = bfhi(u.x); g[2] = bflo(u.y); g[3] = bfhi(u.y); g[4] = bflo(u.z); g[5] = bfhi(u.z); g[6] = bflo(u.w); g[7] = bfhi(u.w);
}
template <class F>
DI void gemm_epilogue(const f32x16 (&acc)[4][2], float* Cs, const float* rssp, int m0, int n0, const int tid_in, F&& quad) {
  int tid = tid_in; asm volatile("" : "+v"(tid));
  const int lane = tid & 63, wave = tid >> 6, wm = wave >> 2, wn = wave & 3;
  const int l32 = lane & 31, h = lane >> 5;
  float* rstd_s = Cs + 128 * LDC;
#pragma unroll 1
  for (int hm = 0; hm < 2; ++hm) {
    __syncthreads();
    if (wm == hm) {
#pragma unroll
      for (int mi = 0; mi < 4; ++mi)
#pragma unroll
        for (int ni = 0; ni < 2; ++ni)
#pragma unroll
          for (int g = 0; g < 4; ++g) {
            const int row = mi * 32 + l32, col = wn * 64 + ni * 32 + 8 * g + 4 * h;
            *(float4*)(Cs + row * LDC + col) = make_float4(acc[mi][ni][4 * g], acc[mi][ni][4 * g + 1], acc[mi][ni][4 * g + 2], acc[mi][ni][4 * g + 3]);
          }
    }
    if (rssp && tid < 128) rstd_s[tid] = row_rstd(rssp, m0 + hm * 128 + tid);
    __syncthreads();
    quad(tid, m0 + hm * 128, n0, Cs);
    quad(tid, m0 + hm * 128, n0 + 128, Cs + 128);
  }
}
#define TILE_MAP(it) const int mt = ((it) & 7) * 8 + (((it) >> 3) & 7), nt = (it) >> 6; const int m0 = mt * 256, n0 = nt * 256;

DI void phase_proj(const Params& p, int l, char* smem, const int wv) {
  const int tid = ltid(wv);
  char* const ws = lws(p);
  const u16* A = (const u16*)(ws + OFF_XB);
  const u16* Bt = (const u16*)(ws + OFF_WIN + l * SZ_WIN);
  u16* proj = (u16*)(ws + OFF_PROJ);
  u16* VT = (u16*)(ws + OFF_VT);
  const float* rssp = (const float*)(ws + OFF_RSSP);
  const float* ropec = (const float*)(ws + OFF_ROPE); const float* ropes = ropec + 2048 * 32;
  float* Cs = (float*)smem; const float* rstd_s = Cs + 128 * LDC;
  for (int it = blockIdx.x; it < 64 * 17; it += gridDim.x) {
    TILE_MAP(it)
    f32x16 acc[4][2]; acc_zero(acc);
    gemm_main(acc, A, 1024, Bt, 1024, 1024, m0, n0, (u16*)smem, tid);
    gemm_epilogue(acc, Cs, rssp, m0, n0, tid, [&](const int tid, int m0q, int n0q, const float* CsQ) {
      const int c8 = (tid & 15) * 8;
      const bool isV = (n0q >= 1024 && n0q < 1536) || (n0q >= 2176 && n0q < 2304);
      if (isV) {
        const int c = tid & 127, tg = tid >> 7;
        const int hh = (n0q < 2048) ? (((n0q - 1024) >> 6) + (c >> 6)) : (8 + (c >> 6));
        const int dim = c & 63; const int b = m0q >> 11, s0 = m0q & 2047;
        u16* dst = VT + ((size_t)(b * 10 + hh) * 64 + dim) * 2048 + s0 + tg * 32;
#pragma unroll
        for (int i = 0; i < 4; ++i) {
          float v[8];
#pragma unroll
          for (int j = 0; j < 8; ++j) { int row = tg * 32 + i * 8 + j; v[j] = CsQ[row * LDC + c] * rstd_s[row]; }
          *(uint4*)(dst + i * 8) = pack8(v);
        }
      } else {
        int type; if (n0q < 512) type = 0; else if (n0q < 1024) type = 1; else if (n0q < 2048) type = 2; else if (n0q < 2176) type = 3; else type = 4;
        const int d0 = c8 & 63;
        float gn[8];
        if (type < 4) {
          const float* qn = p.qk_norm + (l * 4 + type) * 64 + d0;
#pragma unroll
          for (int j = 0; j < 8; ++j) gn[j] = qn[j];
        } else {
          const float* gb = p.gate_bias + l * 2048 + (n0q - 2304) + c8;
#pragma unroll
          for (int j = 0; j < 8; ++j) gn[j] = gb[j];
        }
#pragma unroll 1
        for (int ps = 0; ps < 4; ++ps) {
          const int row = ps * 32 + (tid >> 4);
          float4 t0 = *(const float4*)(CsQ + row * LDC + c8), t1 = *(const float4*)(CsQ + row * LDC + c8 + 4);
          float v[8] = {t0.x, t0.y, t0.z, t0.w, t1.x, t1.y, t1.z, t1.w};
          const float rs = rstd_s[row];
#pragma unroll
          for (int j = 0; j < 8; ++j) v[j] *= rs;
          if (type < 4) {
            float ss = 0.f;
#pragma unroll
            for (int j = 0; j < 8; ++j) ss += v[j] * v[j];
            ss += __shfl_xor(ss, 1); ss += __shfl_xor(ss, 2); ss += __shfl_xor(ss, 4);
            const float r = rsqrtf(ss * (1.f / 64.f) + EPS_);
#pragma unroll
            for (int j = 0; j < 8; ++j) v[j] = v[j] * r * gn[j];
            if (type >= 2) {
              float pv[8];
#pragma unroll
              for (int j = 0; j < 8; ++j) pv[j] = __shfl_xor(v[j], 4);
              const int pos = (m0q + row) & 2047; const int dd = d0 & 31;
              float4 c0 = *(const float4*)(ropec + pos * 32 + dd), c1 = *(const float4*)(ropec + pos * 32 + dd + 4);
              float4 s0 = *(const float4*)(ropes + pos * 32 + dd), s1 = *(const float4*)(ropes + pos * 32 + dd + 4);
              float cc[8] = {c0.x, c0.y, c0.z, c0.w, c1.x, c1.y, c1.z, c1.w};
              float sn[8] = {s0.x, s0.y, s0.z, s0.w, s1.x, s1.y, s1.z, s1.w};
              const bool lo = d0 < 32;
#pragma unroll
              for (int j = 0; j < 8; ++j) v[j] = lo ? (v[j] * cc[j] - pv[j] * sn[j]) : (pv[j] * sn[j] + v[j] * cc[j]);
            }
            if (type == 0 || type == 2) {
#pragma unroll
              for (int j = 0; j < 8; ++j) v[j] *= 0.125f;
            }
          } else {
#pragma unroll
            for (int j = 0; j < 8; ++j) v[j] = __builtin_amdgcn_rcpf(1.f + __expf(-(v[j] + gn[j])));
          }
          *(uint4*)(proj + (size_t)(m0q + row) * NC_ + n0q + c8) = pack8(v);
        }
      }
    });
  }
  if (l == 0) {
    const int G = gridDim.x, ntile = 64 * 17;
    const int last0 = ((ntile - 1) / G) * G;
    const int nbusy = ntile - last0;
    int blk = (int)blockIdx.x - nbusy, nblk = G - nbusy;
    if (nblk <= 0) { blk = blockIdx.x; nblk = G; }
    if (blk >= 0) {
      convert_rows_fp8(p.peer_down + (size_t)16384 * 1024, (unsigned char*)(ws + OFF_PD + SZ_PE), (size_t)16384 * 1024 / 16, p.norm_ffn + 1024, PD_SCALE, tid, blk, nblk);
      convert_rows_fp8(p.peer_up + (size_t)16384 * 1024, (unsigned char*)(ws + OFF_PU + SZ_PE), (size_t)16384 * 1024 / 16, nullptr, PU_SCALE, tid, blk, nblk);
    }
  }
}

DI void phase_merge(const Params& p, int l, char* smem, const int wv) {
  const int tid = ltid(wv);
  char* const ws = lws(p);
  const u16* oab = (const u16*)(ws + OFF_OAB);
  const u16* wna = (const u16*)(ws + OFF_WNA + l * SZ_WBR);
  const u16* wsw = (const u16*)(ws + OFF_WSWA + l * SZ_WBR);
  const u16* proj = (const u16*)(ws + OFF_PROJ);
  u16* merged = (u16*)(ws + OFF_MERGED);
  float* Cs = (float*)smem;
  for (int it = blockIdx.x; it < 64 * 4; it += gridDim.x) {
    TILE_MAP(it)
    f32x16 acc[4][2]; acc_zero(acc);
    gemm_main(acc, oab, 1024, wna, 512, 512, m0, n0, (u16*)smem, tid);
    gemm_epilogue(acc, Cs, nullptr, m0, n0, tid, [&](const int tid, int m0q, int n0q, const float* CsQ) {
      const int c8 = (tid & 15) * 8;
#pragma unroll 1
      for (int ps = 0; ps < 4; ++ps) {
        const int row = ps * 32 + (tid >> 4);
        float4 t0 = *(const float4*)(CsQ + row * LDC + c8), t1 = *(const float4*)(CsQ + row * LDC + c8 + 4);
        float g[8]; unpack8(*(const uint4*)(proj + (size_t)(m0q + row) * NC_ + 2304 + n0q + c8), g);
        float v[8] = {t0.x * g[0], t0.y * g[1], t0.z * g[2], t0.w * g[3], t1.x * g[4], t1.y * g[5], t1.z * g[6], t1.w * g[7]};
        *(uint4*)(merged + (size_t)(m0q + row) * 1024 + n0q + c8) = pack8(v);
      }
    });
    acc_zero(acc);
    gemm_main(acc, oab + 512, 1024, wsw, 512, 512, m0, n0, (u16*)smem, tid);
    gemm_epilogue(acc, Cs, nullptr, m0, n0, tid, [&](const int tid, int m0q, int n0q, const float* CsQ) {
      const int c8 = (tid & 15) * 8;
#pragma unroll 1
      for (int ps = 0; ps < 4; ++ps) {
        const int row = ps * 32 + (tid >> 4);
        float4 t0 = *(const float4*)(CsQ + row * LDC + c8), t1 = *(const float4*)(CsQ + row * LDC + c8 + 4);
        float g[8]; unpack8(*(const uint4*)(proj + (size_t)(m0q + row) * NC_ + 2304 + 1024 + n0q + c8), g);
        u16* mp = merged + (size_t)(m0q + row) * 1024 + n0q + c8;
        float q[8]; unpack8(*(const uint4*)mp, q);
        float v[8] = {q[0] + t0.x * g[0], q[1] + t0.y * g[1], q[2] + t0.z * g[2], q[3] + t0.w * g[3], q[4] + t1.x * g[4], q[5] + t1.y * g[5], q[6] + t1.z * g[6], q[7] + t1.w * g[7]};
        *(uint4*)mp = pack8(v);
      }
    });
  }
}

DI void phase_out(const Params& p, int l, char* smem, const int wv) {
  const int tid = ltid(wv);
  char* const ws = lws(p);
  const u16* merged = (const u16*)(ws + OFF_MERGED);
  const u16* wout = (const u16*)(ws + OFF_WOUT + l * SZ_WOUT);
  u16* xb = (u16*)(ws + OFF_XB); float* rssp = (float*)(ws + OFF_RSSP);
  const float* xold = (l == 0) ? p.x : p.out;
  float* Cs = (float*)smem;
  for (int it = blockIdx.x; it < 64 * 4; it += gridDim.x) {
    TILE_MAP(it)
    f32x16 acc[4][2]; acc_zero(acc);
    gemm_main(acc, merged, 1024, wout, 1024, 1024, m0, n0, (u16*)smem, tid);
    gemm_epilogue(acc, Cs, nullptr, m0, n0, tid, [&](const int tid, int m0q, int n0q, const float* CsQ) {
      const int c8 = (tid & 15) * 8;
#pragma unroll 1
      for (int ps = 0; ps < 4; ++ps) {
        const int row = ps * 32 + (tid >> 4);
        float4 t0 = *(const float4*)(CsQ + row * LDC + c8), t1 = *(const float4*)(CsQ + row * LDC + c8 + 4);
        const size_t o = (size_t)(m0q + row) * 1024 + n0q + c8;
        float4 x0 = *(const float4*)(xold + o), x1 = *(const float4*)(xold + o + 4);
        float v[8] = {x0.x + t0.x, x0.y + t0.y, x0.z + t0.z, x0.w + t0.w, x1.x + t1.x, x1.y + t1.y, x1.z + t1.z, x1.w + t1.w};
        *(float4*)(p.out + o) = make_float4(v[0], v[1], v[2], v[3]);
        *(float4*)(p.out + o + 4) = make_float4(v[4], v[5], v[6], v[7]);
        *(uint4*)(xb + o) = pack8(v);
        float ss = 0.f;
#pragma unroll
        for (int j = 0; j < 8; ++j) ss += v[j] * v[j];
        ss += dppf<0xB1>(ss); ss += dppf<0x4E>(ss); ss += dppf<0x124>(ss); ss += dppf<0x128>(ss);
        if ((tid & 15) == 0) rssp[(size_t)(m0q + row) * 8 + (n0q >> 7)] = ss;
      }
    });
  }
}

DI void phase_pq(const Params& p, int l, char* smem, const int wv) {
  const int tid = ltid(wv);
  char* const ws = lws(p);
  const u16* A = (const u16*)(ws + OFF_XB);
  const u16* Bt = (const u16*)(ws + OFF_WQ + l * SZ_WQ);
  u16* pq = (u16*)(ws + OFF_PQ);
  const float* rssp = (const float*)(ws + OFF_RSSP);
  float* Cs = (float*)smem; const float* rstd_s = Cs + 128 * LDC;
  for (int it = blockIdx.x; it < 64 * 8; it += gridDim.x) {
    TILE_MAP(it)
    f32x16 acc[4][2]; acc_zero(acc);
    gemm_main(acc, A, 1024, Bt, 1024, 1024, m0, n0, (u16*)smem, tid);
    gemm_epilogue(acc, Cs, rssp, m0, n0, tid, [&](const int tid, int m0q, int n0q, const float* CsQ) {
      const int c8 = (tid & 15) * 8;
#pragma unroll 1
      for (int ps = 0; ps < 4; ++ps) {
        const int row = ps * 32 + (tid >> 4);
        float4 t0 = *(const float4*)(CsQ + row * LDC + c8), t1 = *(const float4*)(CsQ + row * LDC + c8 + 4);
        const float rs = rstd_s[row];
        float v[8] = {t0.x * rs, t0.y * rs, t0.z * rs, t0.w * rs, t1.x * rs, t1.y * rs, t1.z * rs, t1.w * rs};
        *(uint4*)(pq + (size_t)(m0q + row) * 2048 + n0q + c8) = pack8(v);
      }
    });
  }
}

constexpr float NEG_ = -1e30f;
DI bf16x8 pack_p(const float* pp) {
  uint4 u = make_uint4(pack2(pp[0], pp[1]), pack2(pp[2], pp[3]), pack2(pp[4], pp[5]), pack2(pp[6], pp[7]));
  return __builtin_bit_cast(bf16x8, u);
}
DI bf16x8 load_vfrag(const u16* vt_row, int key0, int h) {
  uint2 a = *(const uint2*)(vt_row + key0 + 4 * h);
  uint2 b = *(const uint2*)(vt_row + key0 + 8 + 4 * h);
  uint4 u = make_uint4(a.x, a.y, b.x, b.y);
  return __builtin_bit_cast(bf16x8, u);
}

template <bool isNA>
DI void attn_items(const Params& p, int l, char* smem, const int wv) {
  const int tid = ltid(wv), lane = tid & 63, wave = tid >> 6;
  char* const ws = lws(p);
  const int l32 = lane & 31, h = lane >> 5;
  const u16* proj = (const u16*)(ws + OFF_PROJ);
  const u16* VT = (const u16*)(ws + OFF_VT);
  u16* oab = (u16*)(ws + OFF_OAB);
  float* rpb_s = (float*)smem + wave * 480;
  const int gw = blockIdx.x * 8 + wave, nw = gridDim.x * 8;
  for (int item0 = gw; item0 < 4096; item0 += nw) {
    const int item = isNA ? item0 : item0 + 4096;
    int b, hd, tokq0, qcol, kcol, vhead, ocol;
    int rq = 0, cq = 0, cs = 0, rs_q = 0, rs_lo = 0, kcs = 0;
    int q0 = 0, kb_lo = 0, kb_hi = 0;
    int tql;
    float m, lsum;
    if (isNA) {
      const int xj = (item >> 3) & 7, li = ((item >> 6) << 3) | (item & 7);
      const int pair = (li >> 6) * 8 + xj; b = pair >> 3; hd = pair & 7;
      const int r0 = ((li >> 2) & 15) * 2, cg = li & 3;
      rq = r0 + (l32 >> 4); cq = cg * 16 + (l32 & 15);
      cs = min(max(cq - 8, 0), 48); rs_q = min(max(rq - 4, 0), 24);
      rs_lo = min(max(r0 - 4, 0), 24); kcs = min(max(cg * 16 - 8, 0), 32);
      const int rs_hi = min(max(r0 - 3, 0), 24);
      tokq0 = b * 2048 + r0 * 64; tql = b * 2048 + rq * 64 + cq;
      qcol = hd * 64; kcol = 512 + hd * 64; vhead = hd; ocol = hd * 64;
      m = NEG_; lsum = 0.f;
      const float* rp = p.na_rpb + (size_t)(l * 8 + hd) * 465;
      for (int i = lane; i < 465; i += 64) rpb_s[i] = rp[i];
      __threadfence_block();
      kb_lo = 0; kb_hi = rs_hi + 8 - rs_lo;
    } else {
      const int it = item - 4096; const int xj = (it >> 3) & 7, li = ((it >> 6) << 3) | (it & 7);
      const int pair = (li >> 8) * 8 + xj; b = pair >> 1; const int nb = (li >> 4) & 15, qw = li & 3; hd = (pair & 1) * 4 + ((li >> 2) & 3);
      q0 = nb * 128 + qw * 32;
      tokq0 = b * 2048 + q0; tql = tokq0 + l32;
      qcol = 1536 + hd * 64; kcol = 2048 + (hd >> 2) * 64; vhead = 8 + (hd >> 2); ocol = 512 + hd * 64;
      m = p.swa_sink[l * 8 + hd]; lsum = (h == 0) ? 1.f : 0.f;
      kb_lo = max(q0 / 32 - 4, 0); kb_hi = min(q0 / 32 + 5, 64);
    }
    bf16x8 qf[4];
    {
      const u16* qp = proj + (size_t)tql * NC_ + qcol + h * 8;
#pragma unroll
      for (int s = 0; s < 4; ++s) qf[s] = *(const bf16x8*)(qp + s * 16);
    }
    f32x16 o0, o1;
#pragma unroll
    for (int i = 0; i < 16; ++i) { o0[i] = 0.f; o1[i] = 0.f; }
    const u16* vt0 = VT + ((size_t)(b * 10 + vhead) * 64 + l32) * 2048;
    const u16* vt1 = vt0 + (size_t)32 * 2048;
    for (int kb = kb_lo; kb < kb_hi; ++kb) {
      int kpos0;
      const int kr = rs_lo + kb;
      if (isNA) kpos0 = kr * 64 + kcs;
      else kpos0 = kb * 32;
      const u16* kp = proj + (size_t)(b * 2048 + kpos0 + l32) * NC_ + kcol + h * 8;
      bf16x8 kf[4];
#pragma unroll
      for (int s = 0; s < 4; ++s) kf[s] = *(const bf16x8*)(kp + s * 16);
      bf16x8 vf0[2], vf1[2];
#pragma unroll
      for (int s2 = 0; s2 < 2; ++s2) { vf0[s2] = load_vfrag(vt0, kpos0 + 16 * s2, h); vf1[s2] = load_vfrag(vt1, kpos0 + 16 * s2, h); }
      f32x16 sc;
#pragma unroll
      for (int i = 0; i < 16; ++i) sc[i] = 0.f;
#pragma unroll
      for (int s = 0; s < 4; ++s) sc = MFMA(kf[s], qf[s], sc);
      float sv[16]; bool ok[16];
      float bm = NEG_;
      if (isNA) {
        const int drb = min(max(kr - rq + 7, 0), 14) * 31;
        const bool rowok = (kr >= rs_q) && (kr < rs_q + 8);
#pragma unroll
        for (int i = 0; i < 16; ++i) {
          const int kc = kcs + (i & 3) + 8 * (i >> 2) + 4 * h;
          ok[i] = rowok && (kc >= cs) && (kc < cs + 16);
          int dc = min(max(kc - cq + 15, 0), 30);
          sv[i] = sc[i] + rpb_s[drb + dc];
          bm = fmaxf(bm, ok[i] ? sv[i] : NEG_);
        }
      } else {
        const int qpos = q0 + l32;
#pragma unroll
        for (int i = 0; i < 16; ++i) {
          const int kpos = kpos0 + (i & 3) + 8 * (i >> 2) + 4 * h;
          int dlt = qpos - kpos; dlt = dlt < 0 ? -dlt : dlt;
          ok[i] = dlt <= 128;
          sv[i] = sc[i];
          bm = fmaxf(bm, ok[i] ? sv[i] : NEG_);
        }
      }
      { auto sw = __builtin_amdgcn_permlane32_swap(__float_as_uint(bm), __float_as_uint(bm), false, false); bm = fmaxf(__uint_as_float(sw[0]), __uint_as_float(sw[1])); }
      const float mn = fmaxf(m, bm);
      const float alpha = __expf(m - mn);
      m = mn;
      float pp[16]; float psum = 0.f;
#pragma unroll
      for (int i = 0; i < 16; ++i) { pp[i] = ok[i] ? __expf(sv[i] - mn) : 0.f; psum += pp[i]; }
      lsum = lsum * alpha + psum;
#pragma unroll
      for (int i = 0; i < 16; ++i) { o0[i] *= alpha; o1[i] *= alpha; }
#pragma unroll
      for (int s2 = 0; s2 < 2; ++s2) {
        bf16x8 pb = pack_p(pp + 8 * s2);
        o0 = MFMA(vf0[s2], pb, o0);
        o1 = MFMA(vf1[s2], pb, o1);
      }
    }
    const float ltot = xsum32(lsum, lsum);
    const float inv = 1.f / ltot;
    u16* op = oab + (size_t)tql * 1024 + ocol;
#pragma unroll
    for (int g = 0; g < 4; ++g) {
      const int d = 8 * g + 4 * h;
      *(uint2*)(op + d) = make_uint2(pack2(o0[4 * g] * inv, o0[4 * g + 1] * inv), pack2(o0[4 * g + 2] * inv, o0[4 * g + 3] * inv));
      *(uint2*)(op + 32 + d) = make_uint2(pack2(o1[4 * g] * inv, o1[4 * g + 1] * inv), pack2(o1[4 * g + 2] * inv, o1[4 * g + 3] * inv));
    }
  }
}
DI void phase_attn(const Params& p, int l, char* smem, const int wv) {
  attn_items<true>(p, l, smem, wv);
  attn_items<false>(p, l, smem, wv);
}

DI void chain_insert(float (&a)[16], float x) {
#pragma unroll
  for (int j = 15; j >= 1; --j) a[j] = __builtin_amdgcn_fmed3f(a[j - 1], a[j], x);
  a[0] = fmaxf(a[0], x);
}
DI void topk_half(float (&lst)[16], const u16* __restrict__ pq_tok, const u16* __restrict__ sk, int l32, int h) {
  bf16x8 qf[8];
#pragma unroll
  for (int s = 0; s < 8; ++s) qf[s] = *(const bf16x8*)(pq_tok + s * 16 + h * 8);
#pragma unroll
  for (int j = 0; j < 16; ++j) lst[j] = -INFINITY;
#pragma unroll 1
  for (int kb = 0; kb < 4; ++kb) {
    f32x16 sc;
#pragma unroll
    for (int i = 0; i < 16; ++i) sc[i] = 0.f;
    const u16* kp = sk + (size_t)(kb * 32 + l32) * 128 + h * 8;
#pragma unroll
    for (int s = 0; s < 8; ++s) { bf16x8 kf = *(const bf16x8*)(kp + s * 16); sc = MFMA(kf, qf[s], sc); }
#pragma unroll
    for (int i = 0; i < 16; ++i) {
      const unsigned key = kb * 32 + (i & 3) + 8 * (i >> 2) + 4 * h;
      chain_insert(lst, __uint_as_float((__float_as_uint(sc[i]) & 0xFFFFFF80u) | key));
    }
  }
  float oth[16];
#pragma unroll
  for (int j = 0; j < 16; ++j) oth[j] = __shfl_xor(lst[j], 32);
#pragma unroll
  for (int j = 0; j < 16; ++j) chain_insert(lst, oth[j]);
}

DI void route_item(const u16* qrow, const u16* __restrict__ sk, int* __restrict__ ridx, float* __restrict__ rg, const int t, const int hh, const int l32, const int h,
                   unsigned char* lut) {
  float A[16], B[16], C[16];
  topk_half(A, qrow, sk, l32, h);
  topk_half(B, qrow + 128, sk + 128 * 128, l32, h);
#pragma unroll
  for (int j = 0; j < 16; ++j) C[j] = -INFINITY;
#pragma unroll
  for (int i = 0; i < 16; ++i)
#pragma unroll
    for (int j = 0; j < 16; ++j)
      if ((i + 1) * (j + 1) <= 16) {
        float s = A[i] + B[j];
        chain_insert(C, __uint_as_float((__float_as_uint(s) & 0xFFFFFF00u) | (unsigned)(i * 16 + j)));
      }
  const float mx = C[0];
  float den = 0.f;
#pragma unroll
  for (int j = 0; j < 16; ++j) den += __expf(C[j] - mx);
  const float rden = 1.f / den;
  if (h == 0) {
    unsigned wa[4], wb[4];
#pragma unroll
    for (int q = 0; q < 4; ++q) {
      wa[q] = (__float_as_uint(A[4 * q]) & 127u) | ((__float_as_uint(A[4 * q + 1]) & 127u) << 8) | ((__float_as_uint(A[4 * q + 2]) & 127u) << 16) | ((__float_as_uint(A[4 * q + 3]) & 127u) << 24);
      wb[q] = (__float_as_uint(B[4 * q]) & 127u) | ((__float_as_uint(B[4 * q + 1]) & 127u) << 8) | ((__float_as_uint(B[4 * q + 2]) & 127u) << 16) | ((__float_as_uint(B[4 * q + 3]) & 127u) << 24);
    }
    *(uint4*)lut = make_uint4(wa[0], wa[1], wa[2], wa[3]);
    *(uint4*)(lut + 16) = make_uint4(wb[0], wb[1], wb[2], wb[3]);
    __threadfence_block();
    int ev[16]; float gv[16];
#pragma unroll
    for (int k = 0; k < 16; ++k) {
      const unsigned code = __float_as_uint(C[k]) & 255u;
      const unsigned ia = lut[code >> 4], ib = lut[16 + (code & 15u)];
      ev[k] = (int)((ia << 7) | ib);
      gv[k] = __expf(C[k] - mx) * rden;
    }
    int4* ip = (int4*)(ridx + (size_t)t * 128 + hh * 16); float4* gp = (float4*)(rg + (size_t)t * 128 + hh * 16);
#pragma unroll
    for (int q = 0; q < 4; ++q) {
      ip[q] = make_int4(ev[4 * q], ev[4 * q + 1], ev[4 * q + 2], ev[4 * q + 3]);
      gp[q] = make_float4(gv[4 * q], gv[4 * q + 1], gv[4 * q + 2], gv[4 * q + 3]);
    }
  }
}

constexpr int QLD = 264;
DI void phase_pqr(const Params& p, int l, char* smem, const int wv) {
  const int tid = ltid(wv);
  char* const ws = lws(p);
  const u16* A = (const u16*)(ws + OFF_XB);
  const u16* Bt = (const u16*)(ws + OFF_WQ + l * SZ_WQ);
  const float* rssp = (const float*)(ws + OFF_RSSP);
  const u16* sk = (const u16*)(ws + OFF_SK + l * SZ_SK);
  int* ridx = (int*)(ws + OFF_RIDX); float* rg = (float*)(ws + OFF_RG);
  u16* qimg = (u16*)smem;
  for (int it = blockIdx.x; it < 64 * 8; it += gridDim.x) {
    TILE_MAP(it)
    f32x16 acc[4][2]; acc_zero(acc);
    gemm_main(acc, A, 1024, Bt, 1024, 1024, m0, n0, (u16*)smem, tid);
    int tq = tid; asm volatile("" : "+v"(tq));
    const int lane = tq & 63, wave = tq >> 6, wm = wave >> 2, wn = wave & 3, l32 = lane & 31, h = lane >> 5;
#pragma unroll
    for (int mi = 0; mi < 4; ++mi) {
      const int row = wm * 128 + mi * 32 + l32;
      const float rs = row_rstd(rssp, m0 + row);
#pragma unroll
      for (int ni = 0; ni < 2; ++ni)
#pragma unroll
        for (int g = 0; g < 4; ++g) {
          const int col = wn * 64 + ni * 32 + 8 * g + 4 * h;
          *(uint2*)(qimg + row * QLD + col) = make_uint2(pack2(acc[mi][ni][4 * g] * rs, acc[mi][ni][4 * g + 1] * rs), pack2(acc[mi][ni][4 * g + 2] * rs, acc[mi][ni][4 * g + 3] * rs));
        }
    }
    __syncthreads();
    route_item(qimg + (wave * 32 + l32) * QLD, sk, ridx, rg, m0 + wave * 32 + l32, nt, l32, h,
               (unsigned char*)smem + 256 * QLD * 2 + (wave * 32 + l32) * 32);
  }
}


DI f2_t cvt8(unsigned w, bool hi) { return hi ? __builtin_amdgcn_cvt_pk_f32_fp8((int)w, true) : __builtin_amdgcn_cvt_pk_f32_fp8((int)w, false); }
DI float dot16_fp8(u32x4 u, const f2_t* x) {
  f2_t acc = {0.f, 0.f};
  acc = __builtin_elementwise_fma(cvt8(u.x, false), x[0], acc); acc = __builtin_elementwise_fma(cvt8(u.x, true), x[1], acc);
  acc = __builtin_elementwise_fma(cvt8(u.y, false), x[2], acc); acc = __builtin_elementwise_fma(cvt8(u.y, true), x[3], acc);
  acc = __builtin_elementwise_fma(cvt8(u.z, false), x[4], acc); acc = __builtin_elementwise_fma(cvt8(u.z, true), x[5], acc);
  acc = __builtin_elementwise_fma(cvt8(u.w, false), x[6], acc); acc = __builtin_elementwise_fma(cvt8(u.w, true), x[7], acc);
  return acc.x + acc.y;
}
DI void axpy16_fp8(f2_t* o, u32x4 v, float c) {
  const f2_t cc = {c, c};
  o[0] = __builtin_elementwise_fma(cvt8(v.x, false), cc, o[0]); o[1] = __builtin_elementwise_fma(cvt8(v.x, true), cc, o[1]);
  o[2] = __builtin_elementwise_fma(cvt8(v.y, false), cc, o[2]); o[3] = __builtin_elementwise_fma(cvt8(v.y, true), cc, o[3]);
  o[4] = __builtin_elementwise_fma(cvt8(v.z, false), cc, o[4]); o[5] = __builtin_elementwise_fma(cvt8(v.z, true), cc, o[5]);
  o[6] = __builtin_elementwise_fma(cvt8(v.w, false), cc, o[6]); o[7] = __builtin_elementwise_fma(cvt8(v.w, true), cc, o[7]);
}

constexpr size_t OFF_PDOT = OFF_PROJ + ((size_t)64 << 20);
constexpr size_t OFF_COEF = OFF_PROJ + ((size_t)128 << 20);

#define GD_ISSUE(U, XA, XC, EA, EB, tt)                                                                \
  {                                                                                                    \
    _Pragma("unroll") for (int b = 0; b < 16; ++b) {                                                   \
      const int e_ = __shfl((b < 8) ? EA : EB, (b & 7) * 8 + rg);                                      \
      U[b] = *(const u32x4*)(tab + ((unsigned)e_ * 128u + (unsigned)(c * 16)));                          \
    }                                                                                                  \
    XA = *(const u32x4*)(xb + (size_t)(tt) * 1024 + j * 128 + c * 16);                                 \
    XC = *(const u32x4*)(xb + (size_t)(tt) * 1024 + j * 128 + c * 16 + 8);                             \
  }
#define GD_COMPUTE(U, XA, XC, tt)                                                                      \
  {                                                                                                    \
    f2_t xf[8];                                                                                        \
    xf[0] = f2_t{bflo(XA.x), bfhi(XA.x)}; xf[1] = f2_t{bflo(XA.y), bfhi(XA.y)}; xf[2] = f2_t{bflo(XA.z), bfhi(XA.z)}; xf[3] = f2_t{bflo(XA.w), bfhi(XA.w)}; \
    xf[4] = f2_t{bflo(XC.x), bfhi(XC.x)}; xf[5] = f2_t{bflo(XC.y), bfhi(XC.y)}; xf[6] = f2_t{bflo(XC.z), bfhi(XC.z)}; xf[7] = f2_t{bflo(XC.w), bfhi(XC.w)}; \
    float d[16];                                                                                       \
    _Pragma("unroll") for (int b = 0; b < 16; ++b) d[b] = dot16_fp8(U[b], xf);                         \
    float r8[8], r4[4], r2[2];                                                                         \
      \
    { const bool up = (lane & 4) != 0;                                                                 \
      _Pragma("unroll") for (int k = 0; k < 8; ++k) { float keep = up ? d[8 + k] : d[k]; float send = up ? d[k] : d[8 + k]; r8[k] = keep + dppf<0x141>(send); } } \
    { const bool up = (lane & 2) != 0;                                                                 \
      _Pragma("unroll") for (int k = 0; k < 4; ++k) { float keep = up ? r8[4 + k] : r8[k]; float send = up ? r8[k] : r8[4 + k]; r4[k] = keep + dppf<0x4E>(send); } } \
    { const bool up = (lane & 1) != 0;                                                                 \
      _Pragma("unroll") for (int k = 0; k < 2; ++k) { float keep = up ? r4[2 + k] : r4[k]; float send = up ? r4[k] : r4[2 + k]; r2[k] = keep + dppf<0xB1>(send); } } \
    _Pragma("unroll") for (int k = 0; k < 2; ++k) pdot[((size_t)j * T_ + (tt)) * 128 + (2 * c + k) * 8 + rg] = r2[k]; \
  }
DI void phase_gdot(const Params& p, int l, char* smem, const int wv) {
  const int tid = ltid(wv), lane = tid & 63, wave = tid >> 6;
  char* const ws = lws(p);
  const int j = blockIdx.x & 7;
  const int wl = (blockIdx.x >> 3) * 8 + wave, nwl = (gridDim.x >> 3) * 8;
  const unsigned char* tab = (const unsigned char*)(ws + OFF_PD + l * SZ_PE) + (size_t)j * 16384 * 128;
  const u16* xb = (const u16*)(ws + OFF_XB);
  const int* ridx = (const int*)(ws + OFF_RIDX);
  float* pdot = (float*)(ws + OFF_PDOT);
  const int rg = lane >> 3, c = lane & 7;
  if (wl >= T_) return;
  u32x4 U0[16], U1[16], XA0, XC0, XA1, XC1;
  int eA0 = ridx[(size_t)wl * 128 + lane], eB0 = ridx[(size_t)wl * 128 + 64 + lane];
  int tn = min(wl + nwl, T_ - 1);
  int eA1 = ridx[(size_t)tn * 128 + lane], eB1 = ridx[(size_t)tn * 128 + 64 + lane];
  GD_ISSUE(U0, XA0, XC0, eA0, eB0, wl)
#pragma unroll 1
  for (int t = wl; t < T_; t += 2 * nwl) {
    const int t1 = t + nwl, t2 = t + 2 * nwl, t3 = t + 3 * nwl;
    if (t1 < T_) GD_ISSUE(U1, XA1, XC1, eA1, eB1, t1)
    { const int tq = min(t2, T_ - 1); eA0 = ridx[(size_t)tq * 128 + lane]; eB0 = ridx[(size_t)tq * 128 + 64 + lane]; }
    GD_COMPUTE(U0, XA0, XC0, t)
    if (t1 < T_) {
      if (t2 < T_) GD_ISSUE(U0, XA0, XC0, eA0, eB0, t2)
      { const int tq = min(t3, T_ - 1); eA1 = ridx[(size_t)tq * 128 + lane]; eB1 = ridx[(size_t)tq * 128 + 64 + lane]; }
      GD_COMPUTE(U1, XA1, XC1, t1)
    }
  }
}
#undef GD_ISSUE
#undef GD_COMPUTE

DI void phase_gcoef(const Params& p, int l, char* smem, const int wv) {
  const int tid = ltid(wv), lane = tid & 63, wave = tid >> 6;
  char* const ws = lws(p);
  const float* rssp = (const float*)(ws + OFF_RSSP); const float* rg_ = (const float*)(ws + OFF_RG);
  const float* pdot = (const float*)(ws + OFF_PDOT); float* coef = (float*)(ws + OFF_COEF);
  const int gw = blockIdx.x * 8 + wave, nw = gridDim.x * 8;
  for (int t = gw; t < T_; t += nw) {
    const float rstd = row_rstd(rssp, t) * (1.f / PD_SCALE);
#pragma unroll
    for (int hh = 0; hh < 2; ++hh) {
      const size_t e = (size_t)t * 128 + hh * 64 + lane;
      float dsum = 0.f;
#pragma unroll
      for (int jj = 0; jj < 8; ++jj) dsum += pdot[(size_t)jj * T_ * 128 + e];
      const float av = dsum * rstd;
      const float act = 0.5f * av * (1.f + erff(av * 0.70710678118654752f));
      coef[e] = rg_[e] * act * (1.f / PU_SCALE);
    }
  }
}

#define GA_ISSUE(U, X1, EA, EB, tt)                                                                    \
  {                                                                                                    \
    _Pragma("unroll") for (int b = 0; b < 16; ++b) {                                                   \
      const int e_ = __shfl((b < 8) ? EA : EB, (b & 7) * 8 + rg);                                      \
      U[b] = *(const u32x4*)(tab + ((unsigned)e_ * 128u + (unsigned)(c * 16)));                          \
    }                                                                                                  \
    X1 = *(const float2*)(p.out + (size_t)(tt) * 1024 + j * 128 + c * 16 + rg * 2);                    \
  }
#define GA_COMPUTE(U, X1, CA, CB, tt)                                                                  \
  {                                                                                                    \
    f2_t of[8];                                                                                        \
    _Pragma("unroll") for (int q = 0; q < 8; ++q) of[q] = f2_t{0.f, 0.f};                              \
    _Pragma("unroll") for (int b = 0; b < 16; ++b) {                                                   \
      const float cf_ = __shfl((b < 8) ? CA : CB, (b & 7) * 8 + rg);                                   \
      axpy16_fp8(of, U[b], cf_);                                                                       \
    }                                                                                                  \
    float o[16];                                                                                       \
    _Pragma("unroll") for (int q = 0; q < 8; ++q) { o[2 * q] = of[q].x; o[2 * q + 1] = of[q].y; }      \
    float r8[8], r4[4], r2[2];                                                                         \
    _Pragma("unroll") for (int k = 0; k < 8; ++k) r8[k] = xsum32(o[k], o[8 + k]);                      \
    _Pragma("unroll") for (int k = 0; k < 4; ++k) r4[k] = xsum16(r8[k], r8[4 + k]);                     \
    { const bool up = (lane & 8) != 0;                                                                 \
      _Pragma("unroll") for (int k = 0; k < 2; ++k) { float keep = up ? r4[2 + k] : r4[k]; float send = up ? r4[k] : r4[2 + k]; r2[k] = keep + dppf<0x128>(send); } } \
    const size_t o_ = (size_t)(tt) * 1024 + j * 128 + c * 16 + rg * 2;                                 \
    const float v0 = X1.x + r2[0], v1 = X1.y + r2[1];                                                  \
    *(float2*)(p.out + o_) = make_float2(v0, v1);                                                      \
    *(unsigned*)(xb + o_) = pack2(v0, v1);                                                             \
    const float ss = wsum_valu(v0 * v0 + v1 * v1);                                                     \
    if (lane == 0) rssp[(size_t)(tt) * 8 + j] = ss;                                                    \
  }
DI void phase_gaxpy(const Params& p, int l, char* smem, const int wv) {
  const int tid = ltid(wv), lane = tid & 63, wave = tid >> 6;
  char* const ws = lws(p);
  const int j = blockIdx.x & 7;
  const int wl = (blockIdx.x >> 3) * 8 + wave, nwl = (gridDim.x >> 3) * 8;
  const unsigned char* tab = (const unsigned char*)(ws + OFF_PU + l * SZ_PE) + (size_t)j * 16384 * 128;
  u16* xb = (u16*)(ws + OFF_XB); float* rssp = (float*)(ws + OFF_RSSP);
  const int* ridx = (const int*)(ws + OFF_RIDX); const float* coef = (const float*)(ws + OFF_COEF);
  const int rg = lane >> 3, c = lane & 7;
  if (wl >= T_) return;
  u32x4 U0[16], U1[16]; float2 X10, X11;
  int eA0 = ridx[(size_t)wl * 128 + lane], eB0 = ridx[(size_t)wl * 128 + 64 + lane];
  float cA0 = coef[(size_t)wl * 128 + lane], cB0 = coef[(size_t)wl * 128 + 64 + lane];
  int tn = min(wl + nwl, T_ - 1);
  int eA1 = ridx[(size_t)tn * 128 + lane], eB1 = ridx[(size_t)tn * 128 + 64 + lane];
  float cA1 = coef[(size_t)tn * 128 + lane], cB1 = coef[(size_t)tn * 128 + 64 + lane];
  GA_ISSUE(U0, X10, eA0, eB0, wl)
#pragma unroll 1
  for (int t = wl; t < T_; t += 2 * nwl) {
    const int t1 = t + nwl, t2 = t + 2 * nwl, t3 = t + 3 * nwl;
    if (t1 < T_) GA_ISSUE(U1, X11, eA1, eB1, t1)
    const float cAc = cA0, cBc = cB0;
    { const int tq = min(t2, T_ - 1); eA0 = ridx[(size_t)tq * 128 + lane]; eB0 = ridx[(size_t)tq * 128 + 64 + lane];
      cA0 = coef[(size_t)tq * 128 + lane]; cB0 = coef[(size_t)tq * 128 + 64 + lane]; }
    GA_COMPUTE(U0, X10, cAc, cBc, t)
    if (t1 < T_) {
      if (t2 < T_) GA_ISSUE(U0, X10, eA0, eB0, t2)
      const float cAd = cA1, cBd = cB1;
      { const int tq = min(t3, T_ - 1); eA1 = ridx[(size_t)tq * 128 + lane]; eB1 = ridx[(size_t)tq * 128 + 64 + lane];
        cA1 = coef[(size_t)tq * 128 + lane]; cB1 = coef[(size_t)tq * 128 + 64 + lane]; }
      GA_COMPUTE(U1, X11, cAd, cBd, t1)
    }
  }
}
#undef GA_ISSUE
#undef GA_COMPUTE

#define XB_TMO      128
#define XB_XCNT(j)  (256  + 64 * (j))
#define XB_XSUB(j)  (1280 + 64 * (j))
#define XB_XGEN(j)  (2304 + 64 * (j))
#define XB_TOP      3328
#define XB_TOPGEN   3392
#define XCD_BAR_WORDS 3456
#define XB_SPIN_CAP (1u << 18)
#define LAS __attribute__((address_space(3)))

__device__ __forceinline__ unsigned xb_ld(unsigned* p)              { return __hip_atomic_load(p, __ATOMIC_RELAXED, __HIP_MEMORY_SCOPE_AGENT); }
__device__ __forceinline__ unsigned xb_add(unsigned* p, unsigned v) { return __hip_atomic_fetch_add(p, v, __ATOMIC_RELAXED, __HIP_MEMORY_SCOPE_AGENT); }
__device__ __forceinline__ unsigned xb_xcc_id() { return (unsigned)__builtin_amdgcn_s_getreg((3 << 11) | 20) & 0xFu; }
#define XB_SPIN(cond, bar) do { unsigned _sp = 0; while (cond) { __builtin_amdgcn_s_sleep(1); \
    if ((++_sp & 255u) == 0u) { if (xb_ld(&(bar)[XB_TMO])) break; if (_sp > XB_SPIN_CAP) { atomicAdd(&(bar)[XB_TMO], 1u); break; } } } } while (0)

struct XcdBarrier {
    unsigned* bar; unsigned x;
    volatile LAS unsigned* st;
};

__device__ __forceinline__ XcdBarrier xcd_barrier_post(unsigned* bar, volatile LAS unsigned* st, const bool t0) {
    XcdBarrier b; b.bar = bar; b.x = xb_xcc_id(); b.st = st;
    if (t0) (void)xb_add(&bar[XB_XCNT(b.x)], 1u);
    return b;
}
__device__ __forceinline__ void xcd_barrier_complete(unsigned* bar, unsigned x, unsigned& nloc, unsigned& nx) {
    const unsigned G = gridDim.x * gridDim.y * gridDim.z;
    unsigned sum, cnt, mine, sp = 0u;
    for (;;) {
        sum = 0u; cnt = 0u; mine = 0u;
#pragma unroll
        for (unsigned j = 0; j < 16; ++j) { const unsigned c = xb_ld(&bar[XB_XCNT(j)]); sum += c; cnt += (c > 0u) ? 1u : 0u; mine = (j == x) ? c : mine; }
        if (sum == G) break;
        __builtin_amdgcn_s_sleep(1);
        if ((++sp & 255u) == 0u) { if (xb_ld(&bar[XB_TMO])) break; if (sp > XB_SPIN_CAP) { atomicAdd(&bar[XB_TMO], 1u); break; } }
    }
    nloc = mine > 0u ? mine : 1u; nx = cnt > 0u ? cnt : 1u;
}

__device__ __forceinline__ void xcd_barrier(const XcdBarrier& b, const bool t0) {
    asm volatile("s_waitcnt vmcnt(0)" ::: "memory");
    __syncthreads();
    if (t0) {
        unsigned* bar = b.bar;
        __builtin_amdgcn_s_waitcnt(0);
        unsigned nloc = b.st[0], nx = b.st[1];
        if (nloc == 0u) { xcd_barrier_complete(bar, b.x, nloc, nx); b.st[0] = nloc; b.st[1] = nx; }
        const unsigned old = xb_add(&bar[XB_XSUB(b.x)], 1u);
        const unsigned gen = old / nloc;
        if (old + 1u == (gen + 1u) * nloc) {
            __builtin_amdgcn_fence(__ATOMIC_RELEASE, "agent");
            asm volatile("s_waitcnt vmcnt(0)" ::: "memory");
            const unsigned og = xb_add(&bar[XB_TOP], 1u);
            const unsigned tg = og / nx;
            if (og + 1u == (tg + 1u) * nx) xb_add(&bar[XB_TOPGEN], 1u);
            else XB_SPIN(xb_ld(&bar[XB_TOPGEN]) == tg, bar);
            __builtin_amdgcn_fence(__ATOMIC_ACQUIRE, "agent");
            xb_add(&bar[XB_XGEN(b.x)], 1u);
            asm volatile("s_waitcnt vmcnt(0)" ::: "memory");
        } else {
            XB_SPIN(xb_ld(&bar[XB_XGEN(b.x)]) == gen, bar);
            __builtin_amdgcn_fence(__ATOMIC_ACQUIRE, "agent");
            asm volatile("s_waitcnt vmcnt(0)" ::: "memory");
        }
    }
    __syncthreads();
}


__global__ void __launch_bounds__(512, 2) mega_kernel(Params p) {
  __shared__ __attribute__((aligned(16))) char smem[147456];
  cg::grid_group grid = cg::this_grid();
#ifndef REP_MASK
#define REP_MASK 0
#endif
#define RUN_PHASE(bit, call) { if (REP_MASK & (bit)) { call; GSYNC() } call; }
  __shared__ __attribute__((aligned(16))) unsigned xb_st[4];
  const int wv = __builtin_amdgcn_readfirstlane((int)(threadIdx.x >> 6));
  unsigned* const bar = (unsigned*)(p.ws + OFF_BAR);
  if (threadIdx.x < 4) xb_st[threadIdx.x] = 0u;
  __syncthreads();
  const XcdBarrier xbar = xcd_barrier_post(bar, (volatile LAS unsigned*)xb_st, wv == 0 && lane_id() == 0);
#define GSYNC() xcd_barrier(xbar, wv == 0 && lane_id() == 0);
  if (p.rep_mask == 0x7fffffff) grid.sync();
  phase_prep(p, smem, wv);
  GSYNC()
#define LAYER(l) {\
    RUN_PHASE(2, phase_proj(p, l, smem, wv)) \
    GSYNC() \
    RUN_PHASE(4, phase_attn(p, l, smem, wv)) \
    GSYNC() \
    RUN_PHASE(8, phase_merge(p, l, smem, wv)) \
    GSYNC() \
    phase_out(p, l, smem, wv); \
    GSYNC() \
    RUN_PHASE(32, phase_pqr(p, l, smem, wv)) \
    GSYNC() \
    RUN_PHASE(128, phase_gdot(p, l, smem, wv)) \
    GSYNC() \
    phase_gcoef(p, l, smem, wv); \
    GSYNC() \
    phase_gaxpy(p, l, smem, wv); \
    if (l == 0) GSYNC() \
  }
  LAYER(0)
  LAYER(1)
}

extern "C" void kernel_launch(void* const* d_in, const int* in_sizes, int n_in, void* d_out, int out_size, void* d_ws,
                              size_t ws_size, hipStream_t stream) {
  static int grid_blocks = 0;
  if (!grid_blocks) {
    int dev = 0, cus = 0, per_cu = 0;
    hipGetDevice(&dev);
    hipDeviceGetAttribute(&cus, hipDeviceAttributeMultiprocessorCount, dev);
    hipOccupancyMaxActiveBlocksPerMultiprocessor(&per_cu, mega_kernel, 512, 0);
    if (per_cu > 1) per_cu = 1;
    if (per_cu < 1) per_cu = 1;
    grid_blocks = cus * per_cu;
  }
  if (ws_size < WS_TOTAL) { fprintf(stderr, "workspace too small: %zu < %zu\n", ws_size, (size_t)WS_TOTAL); return; }
  Params p{};
  p.x = (const float*)d_in[0]; p.norm_mix = (const float*)d_in[1]; p.w_in = (const float*)d_in[2];
  p.gate_bias = (const float*)d_in[3]; p.qk_norm = (const float*)d_in[4]; p.na_rpb = (const float*)d_in[5];
  p.swa_sink = (const float*)d_in[6]; p.w_bna = (const float*)d_in[7]; p.w_bswa = (const float*)d_in[8];
  p.w_out = (const float*)d_in[9]; p.norm_ffn = (const float*)d_in[10]; p.peer_query = (const float*)d_in[11];
  p.peer_sub = (const float*)d_in[12]; p.peer_down = (const float*)d_in[13]; p.peer_up = (const float*)d_in[14];
  p.out = (float*)d_out; p.ws = (char*)d_ws;
  p.ph_lo = 0; p.ph_hi = 15;
  p.rep_mask = 0; p.pad_ = 0;
  hipMemsetAsync((char*)d_ws + OFF_BAR, 0, (size_t)XCD_BAR_WORDS * 4, stream);
  void* args[] = {&p};
  hipError_t e = hipLaunchCooperativeKernel((void*)mega_kernel, dim3(grid_blocks), dim3(512), args, 0, stream);
  if (e != hipSuccess) fprintf(stderr, "cooperative launch failed: %s (grid %d)\n", hipGetErrorString(e), grid_blocks);
}
```
